# Optimizing an MI355X kernel written in HIP

```python
import jax, jax.numpy as jnp
from jax import lax
import numpy as np

D_MODEL = 1024
BATCH = 2
SEQ = 8192
DEPTH = 2
DEC_BATCH = 16
DEC_SEQ = 32
PAST_LEN = 4096

CHUNK = 64
N_A = DEPTH // 2
N_B = DEPTH - N_A
GLA_HEADS = 4
GLA_DK = D_MODEL // 2 // GLA_HEADS
GLA_DV = D_MODEL // GLA_HEADS
GLA_GATE_RANK = 16
GLA_TAU = 16.0
MLA_HEADS = 8
NOPE_DIM = 128
ROPE_DIM = 64
V_DIM = 128
Q_RANK = 512
KV_RANK = 256
ROPE_THETA = 10000.0
Q_BLOCK = 128
D_FF = 2816
CONV_W = 3
EPS = 1e-6

kernel_name = "yoco_gla_mla_convglu_stream_step"


def rmsnorm(x, g):
    xf = x.astype(jnp.float32)
    y = xf * lax.rsqrt(jnp.mean(xf * xf, axis=-1, keepdims=True) + EPS)
    return (y * g.astype(jnp.float32)).astype(x.dtype)


def rope(x, pos):
    half = ROPE_DIM // 2
    inv = ROPE_THETA ** (-jnp.arange(half, dtype=jnp.float32) * 2.0 / ROPE_DIM)
    ang = pos.astype(jnp.float32)[:, None] * inv[None, :]
    shp = (ang.shape[0],) + (1,) * (x.ndim - 3) + (half,)
    cos, sin = jnp.cos(ang).reshape(shp), jnp.sin(ang).reshape(shp)
    xf = x.astype(jnp.float32)
    x1, x2 = xf[..., :half], xf[..., half:]
    return jnp.concatenate([x1 * cos - x2 * sin, x1 * sin + x2 * cos], axis=-1).astype(x.dtype)


def causal_dwconv(u, prev, w, b):
    L = u.shape[1]
    full = jnp.concatenate([prev.astype(u.dtype), u], axis=1)
    out = b + sum(full[:, i:i + L] * w[i] for i in range(CONV_W))
    return out, full[:, -(CONV_W - 1):]


def conv_glu(h, prev, w_in, conv_w, conv_b, w_out):
    g, u = jnp.split(h @ w_in, [D_FF], axis=-1)
    gc, new_prev = causal_dwconv(g, prev, conv_w, conv_b)
    return (jax.nn.gelu(gc, approximate=False) * u) @ w_out, new_prev


def gla_chunk_step(S, inp):
    q, k, v, log_a = inp
    L = q.shape[2]
    b = jnp.cumsum(log_a, axis=2)
    causal = jnp.tril(jnp.ones((L, L), dtype=bool))[:, :, None]
    diff = b[:, :, :, None, :] - b[:, :, None, :, :]
    decay = jnp.exp(jnp.where(causal, diff, -jnp.inf))
    scores = jnp.sum(q[:, :, :, None, :] * k[:, :, None, :, :] * decay, axis=-1)
    o = jnp.einsum('bhij,bhjv->bhiv', scores, v) + jnp.einsum('bhid,bhdv->bhiv', q * jnp.exp(b), S)
    b_last = b[:, :, -1:, :]
    S_new = jnp.exp(b_last[:, :, 0, :])[..., None] * S + jnp.einsum('bhjd,bhjv->bhdv', k * jnp.exp(b_last - b), v)
    return S_new, o


def gla_mixer(h, S0, w_in, w_a1, w_a2, b_a, out_norm, w_out):
    B, L, _ = h.shape
    dk, dv = GLA_HEADS * GLA_DK, GLA_HEADS * GLA_DV
    q, k, v, r = jnp.split(h @ w_in, [dk, 2 * dk, 2 * dk + dv], axis=-1)
    log_a = jax.nn.log_sigmoid(((h @ w_a1) @ w_a2 + b_a).astype(jnp.float32)) / GLA_TAU

    def heads(t, d):
        return t.reshape(B, L, GLA_HEADS, d).transpose(0, 2, 1, 3).astype(jnp.float32)

    c = min(CHUNK, L)
    n = L // c

    def chunks(t):
        return t.reshape(B, GLA_HEADS, n, c, t.shape[-1]).transpose(2, 0, 1, 3, 4)

    xs = (chunks(heads(q, GLA_DK) * GLA_DK ** -0.5), chunks(heads(k, GLA_DK)),
          chunks(heads(v, GLA_DV)), chunks(heads(log_a, GLA_DK)))
    S, o = lax.scan(gla_chunk_step, S0.astype(jnp.float32), xs)
    o = o.transpose(1, 0, 3, 2, 4).reshape(B, L, GLA_HEADS, GLA_DV)
    o = rmsnorm(o, out_norm).reshape(B, L, dv).astype(h.dtype) * jax.nn.silu(r)
    return o @ w_out, S.astype(S0.dtype)


def mla_shared_kv(s, pos, past_ckv, past_kpe, kv_stream_norm, w_mla_dkv, mla_kv_norm,
                  mla_kp_norm, w_mla_ukv, mla_kn_norm):
    h = rmsnorm(s, kv_stream_norm)
    ckv, kpe = jnp.split(h @ w_mla_dkv, [KV_RANK], axis=-1)
    ckv = rmsnorm(ckv, mla_kv_norm)
    kpe = rope(rmsnorm(kpe, mla_kp_norm), pos)
    if past_ckv is None:
        all_ckv, all_kpe, k_pos = ckv, kpe, pos
    else:
        all_ckv = jnp.concatenate([past_ckv.astype(ckv.dtype), ckv], axis=1)
        all_kpe = jnp.concatenate([past_kpe.astype(kpe.dtype), kpe], axis=1)
        k_pos = jnp.arange(past_ckv.shape[1] + s.shape[1], dtype=jnp.int32)
    B, T, _ = all_ckv.shape
    kv = (all_ckv @ w_mla_ukv).reshape(B, T, MLA_HEADS, NOPE_DIM + V_DIM)
    k_nope = rmsnorm(kv[..., :NOPE_DIM], mla_kn_norm)
    v = kv[..., NOPE_DIM:]
    return ckv, kpe, k_nope, all_kpe, v, k_pos


def mla_attend(q_nope, q_pe, q_pos, k_nope, k_pe, v, k_pos):
    B, Lq = q_nope.shape[:2]
    scale = (NOPE_DIM + ROPE_DIM) ** -0.5
    k_chunk = k_pos // CHUNK

    def block(args):
        qn, qp, qpos = args
        s = (jnp.einsum('bqhd,bkhd->bhqk', qn, k_nope, preferred_element_type=jnp.float32)
             + jnp.einsum('bqhd,bkd->bhqk', qp, k_pe, preferred_element_type=jnp.float32)) * scale
        mask = k_chunk[None, :] <= (qpos // CHUNK)[:, None]
        p = jax.nn.softmax(jnp.where(mask, s, -jnp.inf), axis=-1)
        return jnp.einsum('bhqk,bkhd->bqhd', p.astype(v.dtype), v)

    if Lq > Q_BLOCK and Lq % Q_BLOCK == 0:
        n = Lq // Q_BLOCK

        def qb(t):
            return t.reshape((B, n, Q_BLOCK) + t.shape[2:]).swapaxes(0, 1)

        o = lax.map(block, (qb(q_nope), qb(q_pe), q_pos.reshape(n, Q_BLOCK)))
        return o.swapaxes(0, 1).reshape(B, Lq, MLA_HEADS, V_DIM)
    return block((q_nope, q_pe, q_pos))


def mla_layer(h, pos, k_nope, k_pe, v, k_pos, w_dq, q_norm, w_uq, qn_norm, qp_norm, w_out):
    B, L, _ = h.shape
    cq = rmsnorm(h @ w_dq, q_norm)
    q = (cq @ w_uq).reshape(B, L, MLA_HEADS, NOPE_DIM + ROPE_DIM)
    q_nope = rmsnorm(q[..., :NOPE_DIM], qn_norm)
    q_pe = rope(rmsnorm(q[..., NOPE_DIM:], qp_norm), pos)
    o = mla_attend(q_nope, q_pe, pos, k_nope, k_pe, v, k_pos)
    return o.reshape(B, L, MLA_HEADS * V_DIM) @ w_out


def run_trunk(x, pos, gla_S0, ffn_prev0, past_ckv, past_kpe,
              norm_mix, norm_ffn, w_ffn_in, ffn_conv_w, ffn_conv_b, w_ffn_out,
              w_gla_in, w_gla_a1, w_gla_a2, b_gla_a, gla_out_norm, w_gla_out,
              w_mla_dq, mla_q_norm, w_mla_uq, mla_qn_norm, mla_qp_norm, w_mla_out,
              kv_stream_norm, w_mla_dkv, mla_kv_norm, w_mla_ukv, mla_kn_norm, mla_kp_norm):
    new_gla, new_ffn = [], []
    new_ckv = new_kpe = None
    shared = None
    for l in range(DEPTH):
        h = rmsnorm(x, norm_mix[l])
        if l < N_A:
            o, S = gla_mixer(h, gla_S0[l], w_gla_in[l], w_gla_a1[l], w_gla_a2[l], b_gla_a[l],
                             gla_out_norm[l], w_gla_out[l])
            new_gla.append(S)
        else:
            if shared is None:
                new_ckv, new_kpe, k_nope, k_pe_all, v_all, k_pos = mla_shared_kv(
                    x, pos, past_ckv, past_kpe, kv_stream_norm, w_mla_dkv, mla_kv_norm,
                    mla_kp_norm, w_mla_ukv, mla_kn_norm)
                shared = (k_nope, k_pe_all, v_all, k_pos)
            j = l - N_A
            o = mla_layer(h, pos, shared[0], shared[1], shared[2], shared[3], w_mla_dq[j],
                          mla_q_norm[j], w_mla_uq[j], mla_qn_norm[j], mla_qp_norm[j], w_mla_out[j])
        x = x + o
        h = rmsnorm(x, norm_ffn[l])
        o, prev = conv_glu(h, ffn_prev0[l], w_ffn_in[l], ffn_conv_w[l], ffn_conv_b[l], w_ffn_out[l])
        new_ffn.append(prev)
        x = x + o
    return x, jnp.stack(new_gla), jnp.stack(new_ffn), new_ckv, new_kpe


def setup_inputs(seed: int = 0) -> dict:
    key = jax.random.key(seed)
    ks = iter(jax.random.split(key, 40))

    def nrm(shape, scale=1.0):
        return scale * jax.random.normal(next(ks), shape, jnp.float32)

    def gain(shape):
        return 1.0 + nrm(shape, 0.02)

    dk, dv = GLA_HEADS * GLA_DK, GLA_HEADS * GLA_DV
    return {
        "x_prompt": nrm((BATCH, SEQ, D_MODEL)),
        "x_sample": nrm((DEC_BATCH, DEC_SEQ, D_MODEL)),
        "state_gla": nrm((N_A, DEC_BATCH, GLA_HEADS, GLA_DK, GLA_DV)),
        "state_ffn_conv": nrm((DEPTH, DEC_BATCH, CONV_W - 1, D_FF)),
        "cache_mla_ckv": nrm((DEC_BATCH, PAST_LEN, KV_RANK)),
        "cache_mla_kpe": nrm((DEC_BATCH, PAST_LEN, ROPE_DIM)),
        "norm_mix": gain((DEPTH, D_MODEL)),
        "norm_ffn": gain((DEPTH, D_MODEL)),
        "w_ffn_in": nrm((DEPTH, D_MODEL, 2 * D_FF), D_MODEL ** -0.5),
        "ffn_conv_w": nrm((DEPTH, CONV_W, D_FF), CONV_W ** -0.5),
        "ffn_conv_b": nrm((DEPTH, D_FF), 0.02),
        "w_ffn_out": nrm((DEPTH, D_FF, D_MODEL), 0.5 * D_FF ** -0.5),
        "w_gla_in": nrm((N_A, D_MODEL, 2 * dk + 2 * dv), D_MODEL ** -0.5),
        "w_gla_a1": nrm((N_A, D_MODEL, GLA_GATE_RANK), D_MODEL ** -0.5),
        "w_gla_a2": nrm((N_A, GLA_GATE_RANK, dk), GLA_GATE_RANK ** -0.5),
        "b_gla_a": nrm((N_A, dk), 0.1),
        "gla_out_norm": gain((N_A, GLA_DV)),
        "w_gla_out": nrm((N_A, dv, D_MODEL), 0.5 * dv ** -0.5),
        "w_mla_dq": nrm((N_B, D_MODEL, Q_RANK), D_MODEL ** -0.5),
        "mla_q_norm": gain((N_B, Q_RANK)),
        "w_mla_uq": nrm((N_B, Q_RANK, MLA_HEADS * (NOPE_DIM + ROPE_DIM)), Q_RANK ** -0.5),
        "mla_qn_norm": gain((N_B, NOPE_DIM)),
        "mla_qp_norm": gain((N_B, ROPE_DIM)),
        "w_mla_out": nrm((N_B, MLA_HEADS * V_DIM, D_MODEL), 0.5 * (MLA_HEADS * V_DIM) ** -0.5),
        "kv_stream_norm": gain((D_MODEL,)),
        "w_mla_dkv": nrm((D_MODEL, KV_RANK + ROPE_DIM), D_MODEL ** -0.5),
        "mla_kv_norm": gain((KV_RANK,)),
        "w_mla_ukv": nrm((KV_RANK, MLA_HEADS * (NOPE_DIM + V_DIM)), KV_RANK ** -0.5),
        "mla_kn_norm": gain((NOPE_DIM,)),
        "mla_kp_norm": gain((ROPE_DIM,)),
    }


def reference(x_prompt, x_sample, state_gla, state_ffn_conv, cache_mla_ckv, cache_mla_kpe,
              norm_mix, norm_ffn, w_ffn_in, ffn_conv_w, ffn_conv_b, w_ffn_out,
              w_gla_in, w_gla_a1, w_gla_a2, b_gla_a, gla_out_norm, w_gla_out,
              w_mla_dq, mla_q_norm, w_mla_uq, mla_qn_norm, mla_qp_norm, w_mla_out,
              kv_stream_norm, w_mla_dkv, mla_kv_norm, w_mla_ukv, mla_kn_norm, mla_kp_norm):
    weights = (norm_mix, norm_ffn, w_ffn_in, ffn_conv_w, ffn_conv_b, w_ffn_out,
               w_gla_in, w_gla_a1, w_gla_a2, b_gla_a, gla_out_norm, w_gla_out,
               w_mla_dq, mla_q_norm, w_mla_uq, mla_qn_norm, mla_qp_norm, w_mla_out,
               kv_stream_norm, w_mla_dkv, mla_kv_norm, w_mla_ukv, mla_kn_norm, mla_kp_norm)
    bp, lp = x_prompt.shape[0], x_prompt.shape[1]
    p_pos = jnp.arange(lp, dtype=jnp.int32)
    gla0 = jnp.zeros((N_A, bp, GLA_HEADS, GLA_DK, GLA_DV), x_prompt.dtype)
    ffn0 = jnp.zeros((DEPTH, bp, CONV_W - 1, D_FF), x_prompt.dtype)
    y_prompt, gla_p, ffn_p, ckv_p, kpe_p = run_trunk(x_prompt, p_pos, gla0, ffn0, None, None, *weights)
    past = cache_mla_ckv.shape[1]
    s_pos = past + jnp.arange(x_sample.shape[1], dtype=jnp.int32)
    y_sample, gla_s, ffn_s, ckv_s, kpe_s = run_trunk(x_sample, s_pos, state_gla, state_ffn_conv,
                                                     cache_mla_ckv, cache_mla_kpe, *weights)
    return (y_prompt, y_sample, gla_p, ffn_p, ckv_p, kpe_p, gla_s, ffn_s, ckv_s, kpe_s)
```

```cpp
#include <hip/hip_runtime.h>
#include <hip/hip_cooperative_groups.h>
#include <cstdio>
#include <cstdint>
#include <cstring>
namespace cg = cooperative_groups;

#ifndef MULTI_LAUNCH
#define MULTI_LAUNCH 0
#endif

#ifndef PHMASK
#define PHMASK 0x7fff
#endif
#define EN(n) ((PHMASK >> (n)) & 1)
#define DI __device__ __forceinline__
typedef unsigned short u16;
using bf16x8 = __attribute__((ext_vector_type(8))) short;
using s16x4  = __attribute__((ext_vector_type(4))) short;
using f32x16 = __attribute__((ext_vector_type(16))) float;
using u32x4  = __attribute__((ext_vector_type(4))) unsigned;
using u32x2  = __attribute__((ext_vector_type(2))) unsigned;
#define MFMA(a, b, c) __builtin_amdgcn_mfma_f32_32x32x16_bf16((a), (b), (c), 0, 0, 0)

constexpr int R = 16896;
constexpr int RP = 16384;
constexpr int DM = 1024;
constexpr int DFF = 2816;
constexpr int TS = 4128;
constexpr float EPS = 1e-6f;
constexpr int NSLOT = 1088;
constexpr int LDS_BYTES = 77824;
constexpr int NPH = 15;

constexpr size_t O_Y = 0;
constexpr size_t O_GLAP = 17301504;
constexpr size_t O_FFNP = 17563648;
constexpr size_t O_CKVP = 17586176;
constexpr size_t O_KPEP = 21780480;
constexpr size_t O_GLAS = 22829056;
constexpr size_t O_FFNS = 24926208;
constexpr size_t O_CKVS = 25106432;
constexpr size_t O_KPES = 25237504;

struct WJob { const float* src; const float* gain; u16* dst; int ld; int K; int nblk; int kind; int ncols; int tile0; };
constexpr int NWJ = 14;

struct Params {
  const float* in[30];
  float* out;
  u16 *Wgla_in, *Wgla_out, *Wffn_in[2], *Wffn_out[2], *Wdkvq, *Wukv, *Wuq, *Wmla_out;
  u16* xb; float* rsp;
  u16 *Qg, *Kg; float* GA; u16 *Rg, *Vt, *US; float* dec;
  u16* act;
  float* RAW; u16 *CQN, *ACKVp, *ACKVs, *AKPEp, *AKPEs, *Knp, *Vtp, *Qb, *ao;
  int* counter; unsigned* bar;
  WJob wj[NWJ];
  int n_wtiles; int pad0;
};

typedef __bf16 bf2_t __attribute__((ext_vector_type(2)));
typedef float f2_t __attribute__((ext_vector_type(2)));
DI u16 f2bf(float x) { return __builtin_bit_cast(u16, (__bf16)x); }
DI float bf2f(u16 h) { return __uint_as_float(((unsigned)h) << 16); }
DI unsigned pack2(float a, float b) { f2_t v; v[0] = a; v[1] = b; return __builtin_bit_cast(unsigned, __builtin_convertvector(v, bf2_t)); }
DI float bflo(unsigned u) { return __uint_as_float(u << 16); }
DI float bfhi(unsigned u) { return __uint_as_float(u & 0xffff0000u); }
DI int crow(int reg, int h) { return (reg & 3) + 8 * (reg >> 2) + 4 * h; }
DI bf16x8 pack8(const f32x16& x, int s) {
  u32x4 p;
  p[0] = pack2(x[8 * s + 0], x[8 * s + 1]); p[1] = pack2(x[8 * s + 2], x[8 * s + 3]);
  p[2] = pack2(x[8 * s + 4], x[8 * s + 5]); p[3] = pack2(x[8 * s + 6], x[8 * s + 7]);
  return __builtin_bit_cast(bf16x8, p);
}
DI f32x16 zero16() { f32x16 z; for (int i = 0; i < 16; ++i) z[i] = 0.f; return z; }
DI float rowscale(const float* rsp, int np, int row) {
  float s = 0.f; for (int p = 0; p < np; ++p) s += rsp[(size_t)p * R + row];
  return rsqrtf(s * (1.0f / 1024.0f) + EPS);
}
DI int row_pos(int row) { return row < RP ? (row & 8191) : 4096 + ((row - RP) & 31); }

DI void prep_wtile(const Params& p, int j, char* smem) {
  int mi = 0;
  for (int i = 1; i < NWJ; ++i) if (j >= p.wj[i].tile0) mi = i;
  const WJob wj = p.wj[mi];
  const int local = j - wj.tile0, nkt = wj.K >> 6;
  const int blk = local / nkt, kt = local - blk * nkt, k0 = kt << 6;
  int col0 = blk * 64, ncols = 64;
  if (wj.kind == 1) { col0 = 0; ncols = wj.ncols; }
  else if (wj.kind == 2) { col0 = (blk & 1) * DFF + 64 * (blk >> 1); }
  else if (wj.kind == 4) { col0 = blk < 16 ? (blk >> 1) * 192 + 64 * (blk & 1) : (blk - 16) * 192 + 128; }
  float* T = (float*)smem;
  const int tid = threadIdx.x;
  {
    const int jc = tid & 63, i0 = tid >> 6;
    float vv[16], gg[16];
    const bool ok = jc < ncols;
    const float* sp = wj.src + (size_t)(k0 + i0) * wj.ld + col0 + jc;
#pragma unroll
    for (int ii = 0; ii < 16; ++ii) {
      vv[ii] = ok ? sp[(size_t)(4 * ii) * wj.ld] : 0.f;
      gg[ii] = wj.gain ? wj.gain[k0 + i0 + 4 * ii] : 1.0f;
    }
#pragma unroll
    for (int ii = 0; ii < 16; ++ii) T[(i0 + 4 * ii) * 65 + jc] = vv[ii] * gg[ii];
  }
  __syncthreads();
  {
    const int jr = tid >> 2, iseg = tid & 3;
    unsigned pk[8];
    for (int q = 0; q < 8; ++q) pk[q] = pack2(T[(iseg * 16 + 2 * q) * 65 + jr], T[(iseg * 16 + 2 * q + 1) * 65 + jr]);
    u16* d = wj.dst + (size_t)(blk * 64 + jr) * wj.K + k0 + iseg * 16;
    u32x4 a, b; a[0] = pk[0]; a[1] = pk[1]; a[2] = pk[2]; a[3] = pk[3]; b[0] = pk[4]; b[1] = pk[5]; b[2] = pk[6]; b[3] = pk[7];
    *(u32x4*)d = a; *(u32x4*)(d + 8) = b;
  }
  __syncthreads();
}

DI void phase_prep(const Params& p, char* smem) {
  const int tid = threadIdx.x, lane = tid & 63, w = tid >> 6;
  if (blockIdx.x == 0) { for (int i = tid; i < 2048; i += 256) p.counter[i] = 0; }
  const int nW = p.n_wtiles, nX = R / 4;
  for (int j = blockIdx.x; j < nW + nX; j += gridDim.x) {
    if (j < nW) { prep_wtile(p, j, smem); continue; }
    const int row = (j - nW) * 4 + w;
    const float* x = row < RP ? p.in[0] + (size_t)row * DM : p.in[1] + (size_t)(row - RP) * DM;
    float ss = 0.f;
    float4 xv[4];
#pragma unroll
    for (int i = 0; i < 4; ++i) xv[i] = *(const float4*)(x + lane * 4 + 256 * i);
#pragma unroll
    for (int i = 0; i < 4; ++i) {
      const float4 v = xv[i];
      ss += v.x * v.x + v.y * v.y + v.z * v.z + v.w * v.w;
      u32x2 o; o[0] = pack2(v.x, v.y); o[1] = pack2(v.z, v.w);
      *(u32x2*)(p.xb + (size_t)row * DM + lane * 4 + 256 * i) = o;
    }
    for (int m = 1; m < 64; m <<= 1) ss += __shfl_xor(ss, m);
    if (lane == 0) p.rsp[row] = ss;
  }
}

constexpr int GSTAGE = 256 * 144;
template <int NS>
DI void gemm_main_t(const u16* __restrict__ Ab, int lda, const u16* __restrict__ Bb, int ldb, int K, char* smem, f32x16 (&acc)[2][2]) {
  int tid = threadIdx.x; asm volatile("" : "+v"(tid));
  const int lane = tid & 63, w = tid >> 6, r = lane & 31, hh = lane >> 5;
  const int wm = w >> 1, wn = w & 1;
  const int lrow = tid >> 3, lkc = tid & 7;
  const unsigned aoff = (unsigned)(lrow * lda + lkc * 8), boff = (unsigned)(lrow * ldb + lkc * 8);
  const unsigned lso = (unsigned)(lrow * 144 + lkc * 16);
  u32x4 ra[NS][4], rb[NS][4];
  for (int tm = 0; tm < 2; ++tm) for (int tn = 0; tn < 2; ++tn) acc[tm][tn] = zero16();
  const int nk = K >> 6;
#define G_LOAD(set, kt_) { const u16* a_ = Ab + (size_t)(kt_) * 64; const u16* b_ = Bb + (size_t)(kt_) * 64; \
    _Pragma("unroll") for (int i = 0; i < 4; ++i) { ra[set][i] = *(const u32x4*)(a_ + (size_t)(32 * i) * lda + aoff); rb[set][i] = *(const u32x4*)(b_ + (size_t)(32 * i) * ldb + boff); } }
#define G_STORE(set, st_) { char* d_ = smem + (st_) * GSTAGE + lso; \
    _Pragma("unroll") for (int i = 0; i < 4; ++i) { *(u32x4*)(d_ + 32 * i * 144) = ra[set][i]; *(u32x4*)(d_ + 128 * 144 + 32 * i * 144) = rb[set][i]; } }
#define G_COMPUTE(st_) { const char* sa = smem + (st_) * GSTAGE; const char* sb = sa + 128 * 144; \
    _Pragma("unroll") for (int ks = 0; ks < 4; ++ks) { bf16x8 af[2], bfr[2]; \
      _Pragma("unroll") for (int t = 0; t < 2; ++t) { \
        af[t] = *(const bf16x8*)(sa + (wm * 64 + t * 32 + r) * 144 + (ks * 16 + hh * 8) * 2); \
        bfr[t] = *(const bf16x8*)(sb + (wn * 64 + t * 32 + r) * 144 + (ks * 16 + hh * 8) * 2); } \
      _Pragma("unroll") for (int tm = 0; tm < 2; ++tm) _Pragma("unroll") for (int tn = 0; tn < 2; ++tn) acc[tm][tn] = MFMA(af[tm], bfr[tn], acc[tm][tn]); } }
#define G_COMPUTE_ST(st_, set, sst_, dost, lset, lkt_, dold) { const char* sa = smem + (st_) * GSTAGE; const char* sb = sa + 128 * 144; char* d_ = smem + (sst_) * GSTAGE + lso; \
    const u16* a_ = Ab + (size_t)(lkt_) * 64; const u16* b_ = Bb + (size_t)(lkt_) * 64; \
    bf16x8 af[2][2], bfr[2][2]; \
    _Pragma("unroll") for (int t = 0; t < 2; ++t) { \
      af[0][t] = *(const bf16x8*)(sa + (wm * 64 + t * 32 + r) * 144 + (hh * 8) * 2); \
      bfr[0][t] = *(const bf16x8*)(sb + (wn * 64 + t * 32 + r) * 144 + (hh * 8) * 2); } \
    _Pragma("unroll") for (int ks = 0; ks < 4; ++ks) { \
      if (ks < 3) { _Pragma("unroll") for (int t = 0; t < 2; ++t) { \
        af[(ks + 1) & 1][t] = *(const bf16x8*)(sa + (wm * 64 + t * 32 + r) * 144 + ((ks + 1) * 16 + hh * 8) * 2); \
        bfr[(ks + 1) & 1][t] = *(const bf16x8*)(sb + (wn * 64 + t * 32 + r) * 144 + ((ks + 1) * 16 + hh * 8) * 2); } } \
      _Pragma("unroll") for (int tm = 0; tm < 2; ++tm) _Pragma("unroll") for (int tn = 0; tn < 2; ++tn) acc[tm][tn] = MFMA(af[ks & 1][tm], bfr[ks & 1][tn], acc[tm][tn]); \
      if (dost) { *(u32x4*)(d_ + 32 * ks * 144) = ra[set][ks]; *(u32x4*)(d_ + 128 * 144 + 32 * ks * 144) = rb[set][ks]; } \
      if (dold) { ra[lset][ks] = *(const u32x4*)(a_ + (size_t)(32 * ks) * lda + aoff); rb[lset][ks] = *(const u32x4*)(b_ + (size_t)(32 * ks) * ldb + boff); } } }
#define G_ITER(j) { const int i_ = kt + (j); if (i_ < nk) { \
      G_COMPUTE_ST(i_ & 1, ((j) + 1) % NS, (i_ + 1) & 1, (i_ + 1 < nk), j, i_ + NS, (i_ + NS < nk)) \
      __syncthreads(); } }
  G_LOAD(0, 0)
  if (1 < nk) G_LOAD(1, 1)
  if (NS > 2) { if (2 < nk) G_LOAD(NS > 2 ? 2 : 0, 2) }
  G_STORE(0, 0)
  __syncthreads();
  for (int kt = 0; kt < nk; kt += NS) { G_ITER(0) G_ITER(1) if (NS > 2) G_ITER(NS > 2 ? 2 : 0) }
#undef G_LOAD
#undef G_STORE
#undef G_COMPUTE
#undef G_COMPUTE_ST
#undef G_ITER
  float* Cs = (float*)smem;
#pragma unroll
  for (int tm = 0; tm < 2; ++tm)
#pragma unroll
    for (int tn = 0; tn < 2; ++tn)
#pragma unroll
      for (int i = 0; i < 16; ++i)
        Cs[(wm * 64 + tm * 32 + crow(i, hh)) * 132 + wn * 64 + tn * 32 + r] = acc[tm][tn][i];
  __syncthreads();
}

DI void gemm_main32(const u16* __restrict__ Ab, int lda, const u16* __restrict__ Bb, int ldb, int K, char* smem, f32x16& acc) {
  int tid = threadIdx.x; asm volatile("" : "+v"(tid));
  const int lane = tid & 63, w = tid >> 6, r = lane & 31, hh = lane >> 5;
  const int lrow = tid >> 3, lkc = tid & 7;
  const unsigned aoff = (unsigned)(lrow * lda + lkc * 8), boff = (unsigned)(lrow * ldb + lkc * 8);
  const unsigned lso = (unsigned)(lrow * 144 + lkc * 16);
  u32x4 ra[3], rb[3][4];
  acc = zero16();
  const int nk = K >> 6;
#define H_LOAD(set, kt_) { const u16* a_ = Ab + (size_t)(kt_) * 64; const u16* b_ = Bb + (size_t)(kt_) * 64; ra[set] = *(const u32x4*)(a_ + aoff); \
    _Pragma("unroll") for (int i = 0; i < 4; ++i) rb[set][i] = *(const u32x4*)(b_ + (size_t)(32 * i) * ldb + boff); }
#define H_STORE(set, st_) { char* d_ = smem + (st_) * GSTAGE + lso; *(u32x4*)d_ = ra[set]; \
    _Pragma("unroll") for (int i = 0; i < 4; ++i) *(u32x4*)(d_ + 128 * 144 + 32 * i * 144) = rb[set][i]; }
#define H_COMPUTE(st_) { const char* sa = smem + (st_) * GSTAGE; const char* sb = sa + 128 * 144; \
    _Pragma("unroll") for (int ks = 0; ks < 4; ++ks) { \
      const bf16x8 af = *(const bf16x8*)(sa + r * 144 + (ks * 16 + hh * 8) * 2); \
      const bf16x8 bq = *(const bf16x8*)(sb + (w * 32 + r) * 144 + (ks * 16 + hh * 8) * 2); \
      acc = MFMA(af, bq, acc); } }
#define H_ITER(j) { const int i_ = kt + (j); if (i_ < nk) { \
      if (i_ + 3 < nk) H_LOAD(j, i_ + 3) \
      H_COMPUTE(i_ & 1) \
      if (i_ + 1 < nk) H_STORE(((j) + 1) % 3, (i_ + 1) & 1) \
      __syncthreads(); } }
  H_LOAD(0, 0)
  if (1 < nk) H_LOAD(1, 1)
  if (2 < nk) H_LOAD(2, 2)
  H_STORE(0, 0)
  __syncthreads();
  for (int kt = 0; kt < nk; kt += 3) { H_ITER(0) H_ITER(1) H_ITER(2) }
#undef H_LOAD
#undef H_STORE
#undef H_COMPUTE
#undef H_ITER
  float* Cs = (float*)smem;
#pragma unroll
  for (int i = 0; i < 16; ++i) Cs[crow(i, hh) * 132 + w * 32 + r] = acc[i];
  __syncthreads();
}

DI void gemm_main(const u16* __restrict__ Ab, int lda, const u16* __restrict__ Bb, int ldb, int K, char* smem, f32x16 (&acc)[2][2]) { gemm_main_t<3>(Ab, lda, Bb, ldb, K, smem, acc); }

DI void gemm_small256(const u16* __restrict__ Ab, int lda, const u16* __restrict__ Bb, int ldb, char* smem, f32x16 (&acc)[2][2]) {
  int tid = threadIdx.x; asm volatile("" : "+v"(tid));
  const int lane = tid & 63, w = tid >> 6, r = lane & 31, hh = lane >> 5;
  const int wm = w >> 1, wn = w & 1;
  const int lrow = tid >> 3, lkc = tid & 7;
  const unsigned aoff = (unsigned)(lrow * lda + lkc * 8), boff = (unsigned)(lrow * ldb + lkc * 8);
  const unsigned lso = (unsigned)(lrow * 144 + lkc * 16);
  u32x4 ra[4], rb[4];
  for (int tm = 0; tm < 2; ++tm) for (int tn = 0; tn < 2; ++tn) acc[tm][tn] = zero16();
#pragma unroll
  for (int i = 0; i < 4; ++i) { ra[i] = *(const u32x4*)(Ab + (size_t)(32 * i) * lda + aoff); rb[i] = *(const u32x4*)(Bb + (size_t)(32 * i) * ldb + boff); }
#pragma unroll
  for (int i = 0; i < 4; ++i) { *(u32x4*)(smem + lso + 32 * i * 144) = ra[i]; *(u32x4*)(smem + 128 * 144 + lso + 32 * i * 144) = rb[i]; }
  __syncthreads();
#pragma unroll 1
  for (int kt = 0; kt < 4; ++kt) {
    const bool more = kt + 1 < 4;
    if (more) {
      const int k0 = (kt + 1) << 6;
#pragma unroll
      for (int i = 0; i < 4; ++i) { ra[i] = *(const u32x4*)(Ab + (size_t)(32 * i) * lda + aoff + k0); rb[i] = *(const u32x4*)(Bb + (size_t)(32 * i) * ldb + boff + k0); }
    }
    const char* sa = smem + (kt & 1) * GSTAGE; const char* sb = sa + 128 * 144;
#pragma unroll
    for (int ks = 0; ks < 4; ++ks) {
      bf16x8 af[2], bfr[2];
#pragma unroll
      for (int t = 0; t < 2; ++t) {
        af[t] = *(const bf16x8*)(sa + (wm * 64 + t * 32 + r) * 144 + (ks * 16 + hh * 8) * 2);
        bfr[t] = *(const bf16x8*)(sb + (wn * 64 + t * 32 + r) * 144 + (ks * 16 + hh * 8) * 2);
      }
#pragma unroll
      for (int tm = 0; tm < 2; ++tm)
#pragma unroll
        for (int tn = 0; tn < 2; ++tn) acc[tm][tn] = MFMA(af[tm], bfr[tn], acc[tm][tn]);
    }
    if (more) {
      char* da = smem + ((kt + 1) & 1) * GSTAGE + lso;
#pragma unroll
      for (int i = 0; i < 4; ++i) { *(u32x4*)(da + 32 * i * 144) = ra[i]; *(u32x4*)(da + 128 * 144 + 32 * i * 144) = rb[i]; }
    }
    __syncthreads();
  }
  float* Cs = (float*)smem;
#pragma unroll
  for (int tm = 0; tm < 2; ++tm)
#pragma unroll
    for (int tn = 0; tn < 2; ++tn)
#pragma unroll
      for (int i = 0; i < 16; ++i)
        Cs[(wm * 64 + tm * 32 + crow(i, hh)) * 132 + wn * 64 + tn * 32 + r] = acc[tm][tn][i];
  __syncthreads();
}

enum { EPI_GLA_IN = 0, EPI_RESID, EPI_FFN_IN, EPI_DKVQ, EPI_UKV, EPI_UQ };

struct GemmDesc {
  const u16* A; int lda; const u16* B; int ldb; int K; int MT; int NT; int epi; int layer;
  const float* xin_p; const float* xin_s; float* xout; int write_xb; int np; int seglen;
};

DI float gelu_exact(float x) { return 0.5f * x * (1.0f + erff(x * 0.70710678118654752f)); }

DI void gemm_phase(const Params& p, const GemmDesc& g, char* smem, int blk0, unsigned xcc) {
  float* Cs = (float*)smem;
  float* rsS = (float*)(smem + 67584);
  float* Hs = rsS + 136;
  float* Hp = Hs + 128;
  float* Hc = (float*)(smem + 73728);
  float* xh = (float*)(smem + 69632);
  const int nseg = (g.MT + g.seglen - 1) / g.seglen;
  int* jsh = (int*)(smem + 76 * 1024 - 16);
  int* ctr = p.counter + 256 + blk0 * 128;
  const int q0 = (int)(xcc & 7u);
  for (;;) {
   __syncthreads();
   if (threadIdx.x == 0) {
     int code = -1;
     int qq = q0; asm volatile("" : "+v"(qq));
     for (int d = 0; d < 8; ++d) {
       const int q = (qq + d) & 7;
       if (g.NT <= 8 && g.seglen == 1) {
         const int mlo = (q * g.MT) >> 3, mhi = ((q + 1) * g.MT) >> 3;
         const int li = atomicAdd(ctr + q * 16, 1);
         const bool sliced = (g.epi == EPI_RESID) && (mhi - mlo == 17);
         const int nfull = sliced ? 16 : (mhi - mlo);
         if (li < nfull * g.NT) { const int mm = li / g.NT; code = (mlo + mm) * 64 + (li - mm * g.NT); break; }
         if (sliced && li < nfull * g.NT + 4 * g.NT) { const int s2 = li - nfull * g.NT; const int sl = s2 / g.NT; code = ((sl + 1) << 20) + (mlo + 16) * 64 + (s2 - sl * g.NT); break; }
         continue;
       }
       const int lo = (q * g.NT) >> 3, hi = ((q + 1) * g.NT) >> 3, ntq = hi - lo;
       if (ntq <= 0) continue;
       const int li = atomicAdd(ctr + q * 16, 1);
       if (li < ntq * nseg) { const int sg = (int)(((float)li + 0.5f) / (float)ntq); code = sg * 64 + lo + (li - sg * ntq); break; }
     }
     jsh[0] = code;
   }
   __syncthreads();
   const int code = jsh[0];
   if (code < 0) break;
   const int nt = code & 63, seg = (code >> 6) & 0x3fff, slc = code >> 20;
   const int mt_end = (seg + 1) * g.seglen < g.MT ? (seg + 1) * g.seglen : g.MT;
   for (int mt = seg * g.seglen; mt < mt_end; ++mt) {
    const bool carried = mt > seg * g.seglen;
    const int m0 = mt * 128 + (slc ? (slc - 1) * 32 : 0), n0 = nt * 128;
    const int ritn = slc ? 4 : 16;
    bool swap = false;
    if (g.epi == EPI_GLA_IN) swap = (nt >= 8 && nt < 16);
    if (g.epi == EPI_UKV) swap = (nt & 1);
    const u16* Ap = g.A + (size_t)m0 * g.lda;
    const u16* Bp = g.B + (size_t)n0 * g.ldb;
    if (g.epi == EPI_RESID && slc) { f32x16 acc1; gemm_main32(Ap, g.lda, Bp, g.ldb, g.K, smem, acc1); }
    else {
      f32x16 acc[2][2];
      if (swap) gemm_main(Bp, g.ldb, Ap, g.lda, g.K, smem, acc);
      else gemm_main(Ap, g.lda, Bp, g.ldb, g.K, smem, acc);
    }
    int tid = threadIdx.x; asm volatile("" : "+v"(tid));
    const int lane = tid & 63;
    if (g.epi == EPI_GLA_IN) {
      if (tid < 128) rsS[tid] = rowscale(p.rsp, 1, m0 + tid);
      __syncthreads();
      for (int it = 0; it < 16; ++it) {
        const int idx = tid + 256 * it, row = idx >> 5, c4 = (idx & 31) * 4;
        float4 v = *(const float4*)&Cs[row * 132 + c4];
        if (swap) {
          u32x2 o; o[0] = pack2(v.x * rsS[c4], v.y * rsS[c4 + 1]); o[1] = pack2(v.z * rsS[c4 + 2], v.w * rsS[c4 + 3]);
          *(u32x2*)(p.Vt + (size_t)((nt - 8) * 128 + row) * R + m0 + c4) = o;
        } else {
          const float rs = rsS[row];
          if (nt < 4) {
            const float s = rs * 0.08838834764831845f;
            u32x2 o; o[0] = pack2(v.x * s, v.y * s); o[1] = pack2(v.z * s, v.w * s);
            *(u32x2*)(p.Qg + (size_t)(m0 + row) * 512 + n0 + c4) = o;
          } else if (nt < 8) {
            u32x2 o; o[0] = pack2(v.x * rs, v.y * rs); o[1] = pack2(v.z * rs, v.w * rs);
            *(u32x2*)(p.Kg + (size_t)(m0 + row) * 512 + (n0 - 512) + c4) = o;
          } else if (nt < 24) {
            u32x2 o; o[0] = pack2(v.x * rs, v.y * rs); o[1] = pack2(v.z * rs, v.w * rs);
            *(u32x2*)(p.Rg + (size_t)(m0 + row) * 1024 + (n0 - 2048) + c4) = o;
          } else if (c4 < 16) {
            float4 o = make_float4(v.x * rs, v.y * rs, v.z * rs, v.w * rs);
            *(float4*)(p.GA + (size_t)(m0 + row) * 16 + c4) = o;
          }
        }
      }
    } else if (g.epi == EPI_RESID) {
      float4 xr[16];
#pragma unroll
      for (int it = 0; it < 16; ++it) {
        const int idx = tid + 256 * (it < ritn ? it : 0), row = idx >> 5, c4 = (idx & 31) * 4;
        const int grow = m0 + row;
        const float* xi = grow < RP ? g.xin_p + (size_t)grow * DM : g.xin_s + (size_t)(grow - RP) * DM;
        xr[it] = *(const float4*)(xi + n0 + c4);
      }
#pragma unroll
      for (int it = 0; it < 16; ++it) if (it < ritn) {
        const int idx = tid + 256 * it, row = idx >> 5, c4 = (idx & 31) * 4;
        float4 v = *(const float4*)&Cs[row * 132 + c4];
        const int grow = m0 + row;
        const float4 x = xr[it];
        v.x += x.x; v.y += x.y; v.z += x.z; v.w += x.w;
        *(float4*)(g.xout + (size_t)grow * DM + n0 + c4) = v;
        if (g.write_xb) {
          u32x2 o; o[0] = pack2(v.x, v.y); o[1] = pack2(v.z, v.w);
          *(u32x2*)(p.xb + (size_t)grow * DM + n0 + c4) = o;
          float ss = v.x * v.x + v.y * v.y + v.z * v.z + v.w * v.w;
          for (int m = 1; m < 32; m <<= 1) ss += __shfl_xor(ss, m);
          if ((lane & 31) == 0) p.rsp[(size_t)nt * R + grow] = ss;
        }
      }
    } else if (g.epi == EPI_FFN_IN) {
      const int l = g.layer;
      const bool halo = (m0 < RP) && ((m0 & 8191) != 0);
      if (tid < 130) { const int rr = m0 - 2 + tid; rsS[tid] = rr >= 0 ? rowscale(p.rsp, 8, rr) : 0.f; }
      const int par = mt & 1;
      if (halo && !carried) {
        *(u32x4*)((char*)xh + tid * 16) = *(const u32x4*)(p.xb + (size_t)(m0 - 2) * DM + tid * 8);
        __syncthreads();
        const int c = tid & 63, hr = (tid >> 6) & 1, kh = tid >> 7;
        const u16* wb = g.B + (size_t)(n0 + c) * DM + kh * 512;
        const char* xa = (const char*)xh + hr * 2048 + kh * 1024;
        float sacc = 0.f;
#pragma unroll 1
        for (int k = 0; k < 512; k += 128) {
          u32x4 wv[16];
#pragma unroll
          for (int q = 0; q < 16; ++q) wv[q] = *(const u32x4*)(wb + k + q * 8);
#pragma unroll
          for (int q = 0; q < 16; ++q) {
            const u32x4 a = *(const u32x4*)(xa + (k + q * 8) * 2);
#pragma unroll
            for (int e = 0; e < 4; ++e) sacc += bflo(a[e]) * bflo(wv[q][e]) + bfhi(a[e]) * bfhi(wv[q][e]);
          }
        }
        Hp[(kh * 2 + hr) * 64 + c] = sacc;
      }
      __syncthreads();
      if (tid < 128) {
        const int c = tid & 63, hr = tid >> 6;
        float hv = 0.f;
        if (halo) hv = carried ? Hc[(par ^ 1) * 128 + hr * 64 + c] : (Hp[hr * 64 + c] + Hp[(2 + hr) * 64 + c]) * rsS[hr];
        Hs[hr * 64 + c] = hv;
        Hc[par * 128 + hr * 64 + c] = Cs[(126 + hr) * 132 + c] * rsS[128 + hr];
      }
      __syncthreads();
      const float* cw = p.in[9] + (size_t)l * 3 * DFF;
      const float* cb = p.in[10] + (size_t)l * DFF;
      const int colh = nt * 64 + (tid & 15) * 4;
      const float4 w0 = *(const float4*)(cw + colh), w1 = *(const float4*)(cw + DFF + colh), w2 = *(const float4*)(cw + 2 * DFF + colh), bb = *(const float4*)(cb + colh);
      for (int it = 0; it < 8; ++it) {
        const int idx = tid + 256 * it, row = idx >> 4, c4 = (idx & 15) * 4;
        const int grow = m0 + row, col = nt * 64 + c4;
        const float rs0 = rsS[row + 2];
        float4 g0 = *(const float4*)&Cs[row * 132 + c4];
        float4 u = *(const float4*)&Cs[row * 132 + 64 + c4];
        g0.x *= rs0; g0.y *= rs0; g0.z *= rs0; g0.w *= rs0;
        float4 g1, g2;
        int t; const float* st = nullptr;
        if (grow < RP) { t = grow & 8191; } else { t = (grow - RP) & 31; st = p.in[3] + ((size_t)(l * 16 + ((grow - RP) >> 5)) * 2) * DFF + col; }
        if (t >= 1) {
          if (row >= 1) { const float rs1 = rsS[row + 1]; g1 = *(const float4*)&Cs[(row - 1) * 132 + c4]; g1.x *= rs1; g1.y *= rs1; g1.z *= rs1; g1.w *= rs1; }
          else g1 = *(const float4*)&Hs[64 + c4];
        } else { g1 = st ? *(const float4*)(st + DFF) : make_float4(0.f, 0.f, 0.f, 0.f); }
        if (t >= 2) {
          if (row >= 2) { const float rs2 = rsS[row]; g2 = *(const float4*)&Cs[(row - 2) * 132 + c4]; g2.x *= rs2; g2.y *= rs2; g2.z *= rs2; g2.w *= rs2; }
          else g2 = *(const float4*)&Hs[row * 64 + c4];
        } else { g2 = st ? *(const float4*)(st + (size_t)t * DFF) : make_float4(0.f, 0.f, 0.f, 0.f); }
        float a0 = gelu_exact(bb.x + w0.x * g2.x + w1.x * g1.x + w2.x * g0.x) * (u.x * rs0);
        float a1 = gelu_exact(bb.y + w0.y * g2.y + w1.y * g1.y + w2.y * g0.y) * (u.y * rs0);
        float a2 = gelu_exact(bb.z + w0.z * g2.z + w1.z * g1.z + w2.z * g0.z) * (u.z * rs0);
        float a3 = gelu_exact(bb.w + w0.w * g2.w + w1.w * g1.w + w2.w * g0.w) * (u.w * rs0);
        u32x2 o; o[0] = pack2(a0, a1); o[1] = pack2(a2, a3);
        *(u32x2*)(p.act + (size_t)grow * DFF + col) = o;
        if (grow < RP) {
          if (t >= 8190) *(float4*)(p.out + O_FFNP + ((size_t)(l * 2 + (grow >> 13)) * 2 + (t - 8190)) * DFF + col) = g0;
        } else if (t >= 30) {
          *(float4*)(p.out + O_FFNS + ((size_t)(l * 16 + ((grow - RP) >> 5)) * 2 + (t - 30)) * DFF + col) = g0;
        }
      }
    } else if (g.epi == EPI_DKVQ) {
      if (tid < 128) rsS[tid] = rowscale(p.rsp, 8, m0 + tid);
      __syncthreads();
      for (int it = 0; it < 16; ++it) {
        const int idx = tid + 256 * it, row = idx >> 5, c4 = (idx & 31) * 4;
        float4 v = *(const float4*)&Cs[row * 132 + c4];
        const float rs = rsS[row];
        v.x *= rs; v.y *= rs; v.z *= rs; v.w *= rs;
        *(float4*)(p.RAW + (size_t)(m0 + row) * 896 + n0 + c4) = v;
      }
    } else if (g.epi == EPI_UKV) {
      const int hd = nt >> 1;
      const int b = m0 >> 13, t0 = m0 & 8191;
      for (int it = 0; it < 16; ++it) {
        const int idx = tid + 256 * it, row = idx >> 5, c4 = (idx & 31) * 4;
        float4 v = *(const float4*)&Cs[row * 132 + c4];
        if (swap) {
          u32x2 o; o[0] = pack2(v.x, v.y); o[1] = pack2(v.z, v.w);
          *(u32x2*)(p.Vtp + ((size_t)((b * 8 + hd) * 128 + row)) * 8192 + t0 + c4) = o;
        } else {
          float ss = v.x * v.x + v.y * v.y + v.z * v.z + v.w * v.w;
          for (int m = 1; m < 32; m <<= 1) ss += __shfl_xor(ss, m);
          const float rs = rsqrtf(ss * (1.0f / 128.0f) + EPS);
          u32x2 o; o[0] = pack2(v.x * rs, v.y * rs); o[1] = pack2(v.z * rs, v.w * rs);
          *(u32x2*)(p.Knp + ((size_t)((b * 8 + hd) * 8192 + t0 + row)) * 128 + c4) = o;
        }
      }
    } else if (g.epi == EPI_UQ) {
      const float QS = 0.07216878364870322f * 1.4426950408889634f;
      const int c4h = (tid & 31) * 4;
      const float4 hg1 = *(const float4*)(p.in[21] + c4h), hg2 = *(const float4*)(p.in[28] + c4h), hgq = *(const float4*)(p.in[22] + (c4h & 63));
      for (int it = 0; it < 16; ++it) {
        const int idx = tid + 256 * it, row = idx >> 5, c4 = (idx & 31) * 4;
        float4 v = *(const float4*)&Cs[row * 132 + c4];
        const int grow = m0 + row;
        float ss = v.x * v.x + v.y * v.y + v.z * v.z + v.w * v.w;
        if (nt < 8) {
          for (int m = 1; m < 32; m <<= 1) ss += __shfl_xor(ss, m);
          const float rs = rsqrtf(ss * (1.0f / 128.0f) + EPS) * QS;
          const float4 g1 = hg1, g2 = hg2;
          u32x2 o; o[0] = pack2(v.x * rs * g1.x * g2.x, v.y * rs * g1.y * g2.y); o[1] = pack2(v.z * rs * g1.z * g2.z, v.w * rs * g1.w * g2.w);
          *(u32x2*)(p.Qb + (size_t)grow * 1536 + nt * 192 + c4) = o;
        } else {
          for (int m = 1; m < 16; m <<= 1) ss += __shfl_xor(ss, m);
          const float rs = rsqrtf(ss * (1.0f / 64.0f) + EPS);
          const int dd = c4 & 63, hd = (nt - 8) * 2 + (c4 >> 6);
          const float4 gq = hgq;
          float own[4] = {v.x * rs * gq.x, v.y * rs * gq.y, v.z * rs * gq.z, v.w * rs * gq.w};
          float res[4];
          const float pos = (float)row_pos(grow);
#pragma unroll
          for (int q = 0; q < 4; ++q) {
            const float other = __shfl_xor(own[q], 8);
            const int di = (dd + q) & 31;
            const float inv = exp2f(-(float)di * (2.0f / 64.0f) * 13.287712379549449f);
            float sn, cs; sincosf(pos * inv, &sn, &cs);
            res[q] = (dd < 32) ? own[q] * cs - other * sn : other * sn + own[q] * cs;
          }
          u32x2 o; o[0] = pack2(res[0] * QS, res[1] * QS); o[1] = pack2(res[2] * QS, res[3] * QS);
          *(u32x2*)(p.Qb + (size_t)grow * 1536 + hd * 192 + 128 + dd) = o;
        }
      }
    }
    __syncthreads();
   }
  }
}

DI void slot_decode(int slot, int& row0, int& h, int& L) {
  if (slot < 1024) { const int ch = slot >> 7, c = slot & 127; row0 = (ch >> 2) * 8192 + c * 64; h = ch & 3; L = 64; }
  else { const int sbh = slot - 1024; row0 = RP + (sbh >> 2) * 32; h = sbh & 3; L = 32; }
}

DI void phase_gla_a(const Params& p, char* smem) {
  float* gaS = (float*)smem;
  float* bcS = (float*)(smem + 4096);
  float* tot = (float*)(smem + 36864);
  u16* keT = (u16*)(smem + 37888);
  const float* w_a2 = p.in[14]; const float* b_a = p.in[15];
  for (int slot = blockIdx.x; slot < NSLOT; slot += gridDim.x) {
    int row0, h, L; slot_decode(slot, row0, h, L);
    int tid = threadIdx.x; asm volatile("" : "+v"(tid));
    const int lane = tid & 63, w = tid >> 6, r = lane & 31, hh = lane >> 5;
    {
      const int t = tid >> 2, j4 = (tid & 3) * 4;
      float4 v = make_float4(0.f, 0.f, 0.f, 0.f);
      if (t < L) v = *(const float4*)(p.GA + (size_t)(row0 + t) * 16 + j4);
      *(float4*)&gaS[t * 16 + j4] = v;
    }
    __syncthreads();
    const int d = tid & 127, half = tid >> 7;
    {
      float w2[16];
#pragma unroll
      for (int j = 0; j < 16; ++j) w2[j] = w_a2[j * 512 + h * 128 + d];
      const float ba = b_a[h * 128 + d];
      float cum = 0.f;
      for (int tt = 0; tt < 32; ++tt) {
        const int t = half * 32 + tt;
        float z = ba;
#pragma unroll
        for (int j = 0; j < 16; ++j) z += gaS[t * 16 + j] * w2[j];
        float la = (fminf(z, 0.f) - log1pf(expf(-fabsf(z)))) * (1.0f / 16.0f);
        if (t >= L) la = 0.f;
        cum += la;
        bcS[t * 128 + d] = cum;
      }
      tot[half * 128 + d] = cum;
    }
    __syncthreads();
    {
      const float blast = tot[d] + tot[128 + d];
      const float off = half ? tot[d] : 0.f;
      u16* qbase = p.Qg + (size_t)row0 * 512 + h * 128;
      u16* kbase = p.Kg + (size_t)row0 * 512 + h * 128;
#pragma unroll 1
      for (int t8 = 0; t8 < 32; t8 += 8) {
        u16 qv[8], kv[8];
#pragma unroll
        for (int q8 = 0; q8 < 8; ++q8) {
          const int t = half * 32 + t8 + q8;
          const unsigned gi = (unsigned)((t < L ? t : 0) * 512 + d);
          qv[q8] = qbase[gi]; kv[q8] = kbase[gi];
        }
#pragma unroll
        for (int q8 = 0; q8 < 8; ++q8) {
          const int t = half * 32 + t8 + q8;
          u16 kev = 0;
          if (t < L) {
            const float b = bcS[t * 128 + d] + off;
            const unsigned gi = (unsigned)(t * 512 + d);
            qbase[gi] = f2bf(bf2f(qv[q8]) * expf(b - blast));
            kev = f2bf(bf2f(kv[q8]) * expf(blast - b));
            kbase[gi] = kev;
          }
          keT[d * 72 + t] = kev;
        }
      }
      if (half == 0) p.dec[(size_t)slot * 128 + d] = expf(blast);
    }
    __syncthreads();
    const int nks = L >> 4;
    for (int rt = 0; rt < 2; ++rt) {
      f32x16 acc[4];
      for (int ct = 0; ct < 4; ++ct) acc[ct] = zero16();
      const u16* vrow = p.Vt + (size_t)(h * 256 + w * 64 + rt * 32 + r) * R + row0 + hh * 8;
      bf16x8 av[4];
#pragma unroll
      for (int s = 0; s < 4; ++s) av[s] = *(const bf16x8*)(vrow + (s < nks ? s : 0) * 16);
#pragma unroll
      for (int s = 0; s < 4; ++s) {
        if (s >= nks) break;
        const bf16x8 a = av[s];
#pragma unroll
        for (int ct = 0; ct < 4; ++ct) {
          const bf16x8 b = *(const bf16x8*)(keT + (ct * 32 + r) * 72 + s * 16 + hh * 8);
          acc[ct] = MFMA(a, b, acc[ct]);
        }
      }
      u16* ub = p.US + (size_t)slot * 32768;
#pragma unroll
      for (int ct = 0; ct < 4; ++ct)
#pragma unroll
        for (int i = 0; i < 16; ++i)
          ub[(w * 64 + rt * 32 + crow(i, hh)) * 128 + ct * 32 + r] = f2bf(acc[ct][i]);
    }
    __syncthreads();
  }
}

DI void phase_gla_scan(const Params& p) {
  const int total = 72 * 16384;
  for (int it = blockIdx.x * 256 + threadIdx.x; it < total; it += gridDim.x * 256) {
    const int ch = it >> 14, e = it & 16383, dv = e >> 6, dk = (e & 63) * 2;
    int nchunk, slot0; float S0 = 0.f, S1 = 0.f; float* outp;
    if (ch < 8) { nchunk = 128; slot0 = ch * 128; outp = p.out + O_GLAP + (size_t)ch * 32768; }
    else {
      const int sbh = ch - 8; nchunk = 1; slot0 = 1024 + sbh; outp = p.out + O_GLAS + (size_t)sbh * 32768;
      S0 = p.in[2][((size_t)sbh * 128 + dk) * 256 + dv]; S1 = p.in[2][((size_t)sbh * 128 + dk + 1) * 256 + dv];
    }
    unsigned* ub = (unsigned*)(p.US + (size_t)slot0 * 32768 + dv * 128 + dk);
    const float* db = p.dec + (size_t)slot0 * 128 + dk;
    if (nchunk == 1) {
      const unsigned u = ub[0]; const float2 dd = *(const float2*)db;
      const float s0 = dd.x * S0, s1 = dd.y * S1;
      ub[0] = pack2(s0, s1);
      S0 = s0 + bflo(u); S1 = s1 + bfhi(u);
    } else {
      for (int c0 = 0; c0 < nchunk; c0 += 8) {
        unsigned u[8]; float2 dd[8];
#pragma unroll
        for (int q = 0; q < 8; ++q) { u[q] = ub[(size_t)(c0 + q) * 16384]; dd[q] = *(const float2*)(db + (size_t)(c0 + q) * 128); }
#pragma unroll
        for (int q = 0; q < 8; ++q) {
          const float s0 = dd[q].x * S0, s1 = dd[q].y * S1;
          ub[(size_t)(c0 + q) * 16384] = pack2(s0, s1);
          S0 = s0 + bflo(u[q]); S1 = s1 + bfhi(u[q]);
        }
      }
    }
    outp[(size_t)dk * 256 + dv] = S0; outp[(size_t)(dk + 1) * 256 + dv] = S1;
  }
}

DI void phase_gla_c(const Params& p, char* smem) {
  const int tid = threadIdx.x, lane = tid & 63, w = tid >> 6, r = lane & 31, hh = lane >> 5;
  float* red = (float*)smem;
  const float* gnorm = p.in[16];
  for (int slot = blockIdx.x; slot < NSLOT; slot += gridDim.x) {
    int row0, h, L; slot_decode(slot, row0, h, L);
    const int nit = L >> 5;
    bf16x8 qf[2][8];
#pragma unroll
    for (int it = 0; it < 2; ++it)
#pragma unroll
      for (int s = 0; s < 8; ++s) {
        if (it < nit) qf[it][s] = *(const bf16x8*)(p.Qg + (size_t)(row0 + it * 32 + r) * 512 + h * 128 + s * 16 + hh * 8);
        else { bf16x8 z; for (int q = 0; q < 8; ++q) z[q] = 0; qf[it][s] = z; }
      }
    f32x16 X00 = zero16(), X01 = zero16(), X11 = zero16();
#pragma unroll
    for (int s = 0; s < 8; ++s) {
      const bf16x8 k0 = *(const bf16x8*)(p.Kg + (size_t)(row0 + r) * 512 + h * 128 + s * 16 + hh * 8);
      X00 = MFMA(k0, qf[0][s], X00);
      if (nit == 2) {
        const bf16x8 k1 = *(const bf16x8*)(p.Kg + (size_t)(row0 + 32 + r) * 512 + h * 128 + s * 16 + hh * 8);
        X01 = MFMA(k0, qf[1][s], X01);
        X11 = MFMA(k1, qf[1][s], X11);
      }
    }
#pragma unroll
    for (int i = 0; i < 16; ++i) { if (crow(i, hh) > r) { X00[i] = 0.f; X11[i] = 0.f; } }
    f32x16 acc[2][2];
    for (int a = 0; a < 2; ++a) for (int b = 0; b < 2; ++b) acc[a][b] = zero16();
#pragma unroll
    for (int s2 = 0; s2 < 2; ++s2) {
      const bf16x8 p00 = pack8(X00, s2), p01 = pack8(X01, s2), p11 = pack8(X11, s2);
#pragma unroll
      for (int rt = 0; rt < 2; ++rt) {
        const u16* vrow = p.Vt + (size_t)(h * 256 + w * 64 + rt * 32 + r) * R + row0 + s2 * 16 + 4 * hh;
        {
          const s16x4 lo = *(const s16x4*)(vrow), hi = *(const s16x4*)(vrow + 8);
          const bf16x8 va = __builtin_shufflevector(lo, hi, 0, 1, 2, 3, 4, 5, 6, 7);
          acc[rt][0] = MFMA(va, p00, acc[rt][0]);
          if (nit == 2) acc[rt][1] = MFMA(va, p01, acc[rt][1]);
        }
        if (nit == 2) {
          const s16x4 lo = *(const s16x4*)(vrow + 32), hi = *(const s16x4*)(vrow + 40);
          const bf16x8 va = __builtin_shufflevector(lo, hi, 0, 1, 2, 3, 4, 5, 6, 7);
          acc[rt][1] = MFMA(va, p11, acc[rt][1]);
        }
      }
    }
#pragma unroll
    for (int s = 0; s < 8; ++s)
#pragma unroll
      for (int rt = 0; rt < 2; ++rt) {
        const bf16x8 sa = *(const bf16x8*)(p.US + (size_t)slot * 32768 + (w * 64 + rt * 32 + r) * 128 + s * 16 + hh * 8);
        acc[rt][0] = MFMA(sa, qf[0][s], acc[rt][0]);
        if (nit == 2) acc[rt][1] = MFMA(sa, qf[1][s], acc[rt][1]);
      }
#pragma unroll
    for (int it = 0; it < 2; ++it) {
      float ss = 0.f;
#pragma unroll
      for (int rt = 0; rt < 2; ++rt)
#pragma unroll
        for (int i = 0; i < 16; ++i) ss += acc[rt][it][i] * acc[rt][it][i];
      ss += __shfl_xor(ss, 32);
      if (hh == 0) red[w * 64 + it * 32 + r] = ss;
    }
    __syncthreads();
    {
      u32x2 rgv[2][2][4];
#pragma unroll
      for (int it = 0; it < 2; ++it)
#pragma unroll
        for (int rt = 0; rt < 2; ++rt)
#pragma unroll
          for (int gq = 0; gq < 4; ++gq) {
            const int ti = (it < nit ? it : 0) * 32 + r;
            rgv[it][rt][gq] = *(const u32x2*)(p.Rg + (size_t)(row0 + ti) * 1024 + h * 256 + w * 64 + rt * 32 + 8 * gq + 4 * hh);
          }
#pragma unroll
      for (int it = 0; it < 2; ++it) {
        if (it < nit) {
          const int ti = it * 32 + r;
          const float tot = red[ti] + red[64 + ti] + red[128 + ti] + red[192 + ti];
          const float rs = rsqrtf(tot * (1.0f / 256.0f) + EPS);
#pragma unroll
          for (int rt = 0; rt < 2; ++rt)
#pragma unroll
            for (int gq = 0; gq < 4; ++gq) {
              const int dv = w * 64 + rt * 32 + 8 * gq + 4 * hh;
              u16* rp = p.Rg + (size_t)(row0 + ti) * 1024 + h * 256 + dv;
              const u32x2 rg = rgv[it][rt][gq];
              const float4 gn = *(const float4*)(gnorm + dv);
              const float r0 = bflo(rg[0]), r1 = bfhi(rg[0]), r2 = bflo(rg[1]), r3 = bfhi(rg[1]);
              const float o0 = acc[rt][it][4 * gq + 0] * rs * gn.x * (r0 / (1.0f + expf(-r0)));
              const float o1 = acc[rt][it][4 * gq + 1] * rs * gn.y * (r1 / (1.0f + expf(-r1)));
              const float o2 = acc[rt][it][4 * gq + 2] * rs * gn.z * (r2 / (1.0f + expf(-r2)));
              const float o3 = acc[rt][it][4 * gq + 3] * rs * gn.w * (r3 / (1.0f + expf(-r3)));
              u32x2 o; o[0] = pack2(o0, o1); o[1] = pack2(o2, o3);
              *(u32x2*)rp = o;
            }
        }
      }
    }
    __syncthreads();
  }
}

DI void phase_e2(const Params& p) {
  const int tid = threadIdx.x, lane = tid & 63, w = tid >> 6;
  const int nRow = R / 4, nC = 8192, nK = 2048;
  for (int j = blockIdx.x; j < nRow + nC + nK; j += gridDim.x) {
    if (j < nRow) {
      const int row = j * 4 + w;
      const float* raw = p.RAW + (size_t)row * 896;
      const int pos = row_pos(row);
      const float4 pre_ckv = *(const float4*)(raw + lane * 4);
      const float pre_kpe = raw[256 + lane];
      const float4 pre_q0 = *(const float4*)(raw + 384 + lane * 8), pre_q1 = *(const float4*)(raw + 384 + lane * 8 + 4);
      {
        const float4 v = pre_ckv;
        float ss = v.x * v.x + v.y * v.y + v.z * v.z + v.w * v.w;
        for (int m = 1; m < 64; m <<= 1) ss += __shfl_xor(ss, m);
        const float rs = rsqrtf(ss * (1.0f / 256.0f) + EPS);
        const float4 g = *(const float4*)(p.in[26] + lane * 4);
        const float4 o = make_float4(v.x * rs * g.x, v.y * rs * g.y, v.z * rs * g.z, v.w * rs * g.w);
        u32x2 ob; ob[0] = pack2(o.x, o.y); ob[1] = pack2(o.z, o.w);
        if (row < RP) {
          *(float4*)(p.out + O_CKVP + (size_t)row * 256 + lane * 4) = o;
          *(u32x2*)(p.ACKVp + (size_t)row * 256 + lane * 4) = ob;
        } else {
          const int rr = row - RP, sb = rr >> 5, t = rr & 31;
          *(float4*)(p.out + O_CKVS + (size_t)rr * 256 + lane * 4) = o;
          *(u32x2*)(p.ACKVs + ((size_t)sb * TS + 4096 + t) * 256 + lane * 4) = ob;
        }
      }
      {
        const float v = pre_kpe;
        float ss = v * v;
        for (int m = 1; m < 64; m <<= 1) ss += __shfl_xor(ss, m);
        const float rs = rsqrtf(ss * (1.0f / 64.0f) + EPS);
        const float own = v * rs * p.in[29][lane];
        const float other = __shfl_xor(own, 32);
        const int di = lane & 31;
        const float inv = exp2f(-(float)di * (2.0f / 64.0f) * 13.287712379549449f);
        float sn, cs; sincosf((float)pos * inv, &sn, &cs);
        const float o = lane < 32 ? own * cs - other * sn : other * sn + own * cs;
        if (row < RP) {
          p.out[O_KPEP + (size_t)row * 64 + lane] = o;
          p.AKPEp[(size_t)row * 64 + lane] = f2bf(o);
        } else {
          const int rr = row - RP, sb = rr >> 5, t = rr & 31;
          p.out[O_KPES + (size_t)rr * 64 + lane] = o;
          p.AKPEs[((size_t)sb * TS + 4096 + t) * 64 + lane] = f2bf(o);
        }
      }
      {
        const float4 v0 = pre_q0, v1 = pre_q1;
        float ss = v0.x * v0.x + v0.y * v0.y + v0.z * v0.z + v0.w * v0.w + v1.x * v1.x + v1.y * v1.y + v1.z * v1.z + v1.w * v1.w;
        for (int m = 1; m < 64; m <<= 1) ss += __shfl_xor(ss, m);
        const float rs = rsqrtf(ss * (1.0f / 512.0f) + EPS);
        const float4 g0 = *(const float4*)(p.in[19] + lane * 8), g1 = *(const float4*)(p.in[19] + lane * 8 + 4);
        u32x4 o;
        o[0] = pack2(v0.x * rs * g0.x, v0.y * rs * g0.y); o[1] = pack2(v0.z * rs * g0.z, v0.w * rs * g0.w);
        o[2] = pack2(v1.x * rs * g1.x, v1.y * rs * g1.y); o[3] = pack2(v1.z * rs * g1.z, v1.w * rs * g1.w);
        *(u32x4*)(p.CQN + (size_t)row * 512 + lane * 8) = o;
      }
    } else if (j < nRow + nC) {
      const size_t e = (size_t)(j - nRow) * 2048 + tid * 8;
      const int sb = (int)(e >> 20); const size_t rem = e & 1048575;
      const float4 a = *(const float4*)(p.in[4] + e), b = *(const float4*)(p.in[4] + e + 4);
      u32x4 o; o[0] = pack2(a.x, a.y); o[1] = pack2(a.z, a.w); o[2] = pack2(b.x, b.y); o[3] = pack2(b.z, b.w);
      *(u32x4*)(p.ACKVs + (size_t)sb * TS * 256 + rem) = o;
    } else {
      const size_t e = (size_t)(j - nRow - nC) * 2048 + tid * 8;
      const int sb = (int)(e >> 18); const size_t rem = e & 262143;
      const float4 a = *(const float4*)(p.in[5] + e), b = *(const float4*)(p.in[5] + e + 4);
      u32x4 o; o[0] = pack2(a.x, a.y); o[1] = pack2(a.z, a.w); o[2] = pack2(b.x, b.y); o[3] = pack2(b.z, b.w);
      *(u32x4*)(p.AKPEs + (size_t)sb * TS * 64 + rem) = o;
    }
  }
}

DI void attn_step(const char* Ks, const char* Vts, const bf16x8 (&qf)[12], f32x16 (&o)[4], float& m, float& l, int r, int hh, int nvalid) {
  f32x16 sv[2]; sv[0] = zero16(); sv[1] = zero16();
#pragma unroll
  for (int k2 = 0; k2 < 2; ++k2)
#pragma unroll
    for (int ks = 0; ks < 12; ++ks) {
      const bf16x8 a = *(const bf16x8*)(Ks + (k2 * 32 + r) * 400 + (ks * 16 + hh * 8) * 2);
      sv[k2] = MFMA(a, qf[ks], sv[k2]);
    }
#pragma unroll
  for (int k2 = 0; k2 < 2; ++k2) {
    float mx = sv[k2][0];
#pragma unroll
    for (int i = 1; i < 16; ++i) mx = fmaxf(mx, sv[k2][i]);
    mx = fmaxf(mx, __shfl_xor(mx, 32));
    const float mn = fmaxf(m, mx);
    const float alpha = __builtin_amdgcn_exp2f(m - mn);
    float ps = 0.f;
#pragma unroll
    for (int i = 0; i < 16; ++i) { const float pv = __builtin_amdgcn_exp2f(sv[k2][i] - mn); ps += pv; sv[k2][i] = pv; }
    l = l * alpha + ps; m = mn;
    if (__any(alpha != 1.0f)) {
#pragma unroll
      for (int dt = 0; dt < 4; ++dt)
#pragma unroll
        for (int i = 0; i < 16; ++i) o[dt][i] *= alpha;
    }
#pragma unroll
    for (int s2 = 0; s2 < 2; ++s2) {
      const bf16x8 pb = pack8(sv[k2], s2);
#pragma unroll
      for (int dt = 0; dt < 4; ++dt) {
        const char* vp = Vts + (dt * 32 + r) * 136 + (k2 * 32 + s2 * 16 + hh * 4) * 2;
        const s16x4 lo = *(const s16x4*)vp, hi = *(const s16x4*)(vp + 16);
        const bf16x8 va = __builtin_shufflevector(lo, hi, 0, 1, 2, 3, 4, 5, 6, 7);
        o[dt] = MFMA(va, pb, o[dt]);
      }
    }
  }
}

DI void attn_step_part(const char* Ks, const char* Vts, const char* Qp, const bf16x8 (&qf)[4], f32x16 (&o)[2], float& m, float& l, int r, int hh, int k2, int dvh) {
  f32x16 s = zero16();
#pragma unroll
  for (int ks = 0; ks < 12; ++ks) {
    bf16x8 qb;
    if (ks < 4) qb = qf[ks < 4 ? ks : 0]; else qb = *(const bf16x8*)(Qp + ((ks - 4) * 16 + hh * 8) * 2);
    const bf16x8 a = *(const bf16x8*)(Ks + (k2 * 32 + r) * 400 + (ks * 16 + hh * 8) * 2);
    s = MFMA(a, qb, s);
  }
  float mx = s[0];
#pragma unroll
  for (int i = 1; i < 16; ++i) mx = fmaxf(mx, s[i]);
  mx = fmaxf(mx, __shfl_xor(mx, 32));
  const float mn = fmaxf(m, mx);
  const float alpha = __builtin_amdgcn_exp2f(m - mn);
  float ps = 0.f;
#pragma unroll
  for (int i = 0; i < 16; ++i) { const float pv = __builtin_amdgcn_exp2f(s[i] - mn); ps += pv; s[i] = pv; }
  l = l * alpha + ps; m = mn;
#pragma unroll
  for (int d2 = 0; d2 < 2; ++d2)
#pragma unroll
    for (int i = 0; i < 16; ++i) o[d2][i] *= alpha;
#pragma unroll
  for (int s2 = 0; s2 < 2; ++s2) {
    const bf16x8 pb = pack8(s, s2);
#pragma unroll
    for (int d2 = 0; d2 < 2; ++d2) {
      const char* vp = Vts + ((dvh * 2 + d2) * 32 + r) * 136 + (k2 * 32 + s2 * 16 + hh * 4) * 2;
      const s16x4 lo = *(const s16x4*)vp, hi = *(const s16x4*)(vp + 16);
      const bf16x8 va = __builtin_shufflevector(lo, hi, 0, 1, 2, 3, 4, 5, 6, 7);
      o[d2] = MFMA(va, pb, o[d2]);
    }
  }
}

DI void attn_store(const Params& p, const f32x16 (&o)[4], float l, int grow, int h, int hh) {
  const float lt = l + __shfl_xor(l, 32);
  const float inv = 1.0f / lt;
#pragma unroll
  for (int dt = 0; dt < 4; ++dt)
#pragma unroll
    for (int gq = 0; gq < 4; ++gq) {
      u32x2 ov; ov[0] = pack2(o[dt][4 * gq] * inv, o[dt][4 * gq + 1] * inv); ov[1] = pack2(o[dt][4 * gq + 2] * inv, o[dt][4 * gq + 3] * inv);
      *(u32x2*)(p.ao + (size_t)grow * 1024 + h * 128 + dt * 32 + 8 * gq + 4 * hh) = ov;
    }
}

DI void attn_prompt_item(const Params& p, char* smem, int b, int h, int mq, int desc) {
  int tid = threadIdx.x; asm volatile("" : "+v"(tid));
  const int lane = tid & 63, w = tid >> 6, r = lane & 31, hh = lane >> 5;
  char* Ks = smem; char* Vts = smem + 25600;
  const int grow = b * 8192 + mq * 128 + w * 32 + r;
  bf16x8 qf[12];
#pragma unroll
  for (int s = 0; s < 12; ++s) qf[s] = *(const bf16x8*)(p.Qb + (size_t)grow * 1536 + h * 192 + s * 16 + hh * 8);
  f32x16 o[4]; for (int dt = 0; dt < 4; ++dt) o[dt] = zero16();
  float m = -INFINITY, l = 0.f;
  const int ntiles = 2 * mq + 2, mytiles = 2 * mq + 1 + (w >> 1);
  const u16* kn = p.Knp + (size_t)(b * 8 + h) * 8192 * 128;
  const u16* kp = p.AKPEp + (size_t)b * 8192 * 64;
  const u16* vt = p.Vtp + (size_t)(b * 8 + h) * 128 * 8192;
  u32x4 rk[4], rp[2], rv[4];
  const unsigned okn = (unsigned)((tid >> 4) * 128 + (tid & 15) * 8);
  const unsigned okp = (unsigned)((tid >> 3) * 64 + (tid & 7) * 8);
  const unsigned ovt = (unsigned)((tid >> 3) * 8192 + (tid & 7) * 8);
  auto gload = [&](int kt) {
    const u16* knt = kn + (size_t)kt * 64 * 128;
    const u16* kpt = kp + (size_t)kt * 64 * 64;
    const u16* vtt = vt + (size_t)kt * 64;
#pragma unroll
    for (int i = 0; i < 4; ++i) rk[i] = *(const u32x4*)(knt + i * 2048 + okn);
#pragma unroll
    for (int i = 0; i < 2; ++i) rp[i] = *(const u32x4*)(kpt + i * 2048 + okp);
#pragma unroll
    for (int i = 0; i < 4; ++i) rv[i] = *(const u32x4*)(vtt + (size_t)i * 32 * 8192 + ovt);
  };
  gload(desc ? ntiles - 1 : 0);
  for (int ki = 0; ki < ntiles; ++ki) {
    const int kt = desc ? ntiles - 1 - ki : ki;
    __syncthreads();
#pragma unroll
    for (int i = 0; i < 4; ++i) { const int c = tid + 256 * i; *(u32x4*)(Ks + (c >> 4) * 400 + (c & 15) * 16) = rk[i]; }
#pragma unroll
    for (int i = 0; i < 2; ++i) { const int c = tid + 256 * i; *(u32x4*)(Ks + (c >> 3) * 400 + 256 + (c & 7) * 16) = rp[i]; }
#pragma unroll
    for (int i = 0; i < 4; ++i) {
      const int c = tid + 256 * i; char* d = Vts + (c >> 3) * 136 + (c & 7) * 16;
      u32x2 a, bq; a[0] = rv[i][0]; a[1] = rv[i][1]; bq[0] = rv[i][2]; bq[1] = rv[i][3];
      *(u32x2*)d = a; *(u32x2*)(d + 8) = bq;
    }
    __syncthreads();
    if (ki + 1 < ntiles) gload(desc ? kt - 1 : kt + 1);
    if (kt < mytiles) attn_step(Ks, Vts, qf, o, m, l, r, hh, 64);
  }
  attn_store(p, o, l, grow, h, hh);
}

DI void attn_sample_item(const Params& p, char* smem, int item, int sb, int h) {
  int tid = threadIdx.x; asm volatile("" : "+v"(tid));
  const int lane = tid & 63, w = tid >> 6, r = lane & 31, hh = lane >> 5;
  char* Ks = smem; char* Vts = smem + 25600;
  const int grow = RP + sb * 32 + r;
  f32x16 o[2]; o[0] = zero16(); o[1] = zero16();
  float m = -INFINITY, l = 0.f;
  const u16* ck = p.ACKVs + (size_t)sb * TS * 256;
  const u16* kpe = p.AKPEs + (size_t)sb * TS * 64;
  const u16* wk = p.Wukv + (size_t)(h * 256) * 256;
  const u16* wv = p.Wukv + (size_t)(h * 256 + 128) * 256;
  u16* sK = p.CQN + (size_t)item * 81920;
  u16* sV = sK + 32768;
  float* sO = (float*)(sK + 65536);
#pragma unroll 1
  for (int c = 0; c < 17; ++c) {
    const int kbase = c * 256;
    int tid = threadIdx.x; asm volatile("" : "+v"(tid));
    const int lane = tid & 63, w = tid >> 6, r = lane & 31, hh = lane >> 5;
    const int grow = RP + sb * 32 + r;
    char* Qp = smem + 43008 + r * 272;
    __syncthreads();
    for (int mt2 = 0; mt2 < 2; ++mt2) {
      if (kbase + mt2 * 128 >= TS) break;
      const u16* arow = ck + (size_t)(kbase + mt2 * 128) * 256;
      f32x16 acc[2][2];
      gemm_main_t<2>(arow, 256, wk, 256, 256, smem, acc);
      {
        const float* Cs = (const float*)smem;
        for (int it = 0; it < 16; ++it) {
          const int idx = tid + 256 * it, row = idx >> 5, c4 = (idx & 31) * 4;
          const float4 v = *(const float4*)&Cs[row * 132 + c4];
          float ss = v.x * v.x + v.y * v.y + v.z * v.z + v.w * v.w;
          for (int mm = 1; mm < 32; mm <<= 1) ss += __shfl_xor(ss, mm);
          const float rs = rsqrtf(ss * (1.0f / 128.0f) + EPS);
          u32x2 ov; ov[0] = pack2(v.x * rs, v.y * rs); ov[1] = pack2(v.z * rs, v.w * rs);
          *(u32x2*)(sK + (size_t)(mt2 * 128 + row) * 128 + c4) = ov;
        }
      }
      __syncthreads();
      gemm_main_t<2>(wv, 256, arow, 256, 256, smem, acc);
      {
        const float* Cs = (const float*)smem;
        for (int it = 0; it < 16; ++it) {
          const int idx = tid + 256 * it, row = idx >> 5, c4 = (idx & 31) * 4;
          const float4 v = *(const float4*)&Cs[row * 132 + c4];
          u32x2 ov; ov[0] = pack2(v.x, v.y); ov[1] = pack2(v.z, v.w);
          *(u32x2*)(sV + (size_t)row * 256 + mt2 * 128 + c4) = ov;
        }
      }
      __syncthreads();
    }
    asm volatile("s_waitcnt vmcnt(0)" ::: "memory");
    __syncthreads();
    __builtin_amdgcn_fence(__ATOMIC_ACQUIRE, "agent");
    bf16x8 qf[4];
#pragma unroll
    for (int s = 0; s < 4; ++s) qf[s] = *(const bf16x8*)(p.Qb + (size_t)grow * 1536 + h * 192 + s * 16 + hh * 8);
    if (w == 0) {
#pragma unroll
      for (int s = 0; s < 8; ++s) *(bf16x8*)(Qp + (s * 16 + hh * 8) * 2) = *(const bf16x8*)(p.Qb + (size_t)grow * 1536 + h * 192 + 64 + s * 16 + hh * 8);
    }
    {
      const int ntl = (TS - kbase) >= 256 ? 4 : ((TS - kbase) + 63) / 64;
      u32x4 pk[4], pp[2], pv[4];
      auto tload = [&](int t4) {
        const int key0 = kbase + t4 * 64;
#pragma unroll
        for (int i = 0; i < 4; ++i) { const int cc = tid + 256 * i; pk[i] = *(const u32x4*)(sK + (size_t)(t4 * 64 + (cc >> 4)) * 128 + (cc & 15) * 8); }
#pragma unroll
        for (int i = 0; i < 2; ++i) {
          const int cc = tid + 256 * i, row = cc >> 3;
          u32x4 v; v[0] = 0; v[1] = 0; v[2] = 0; v[3] = 0;
          if (key0 + row < TS) v = *(const u32x4*)(kpe + (size_t)(key0 + row) * 64 + (cc & 7) * 8);
          pp[i] = v;
        }
#pragma unroll
        for (int i = 0; i < 4; ++i) { const int cc = tid + 256 * i; pv[i] = *(const u32x4*)(sV + (size_t)(cc >> 3) * 256 + t4 * 64 + (cc & 7) * 8); }
      };
      tload(0);
      for (int t4 = 0; t4 < ntl; ++t4) {
        const int key0 = kbase + t4 * 64;
        const int nvalid = (TS - key0) < 64 ? (TS - key0) : 64;
#pragma unroll
        for (int i = 0; i < 4; ++i) { const int cc = tid + 256 * i; *(u32x4*)(Ks + (cc >> 4) * 400 + (cc & 15) * 16) = pk[i]; }
#pragma unroll
        for (int i = 0; i < 2; ++i) { const int cc = tid + 256 * i; *(u32x4*)(Ks + (cc >> 3) * 400 + 256 + (cc & 7) * 16) = pp[i]; }
#pragma unroll
        for (int i = 0; i < 4; ++i) {
          const int cc = tid + 256 * i; char* d = Vts + (cc >> 3) * 136 + (cc & 7) * 16;
          u32x2 a, bq; a[0] = pv[i][0]; a[1] = pv[i][1]; bq[0] = pv[i][2]; bq[1] = pv[i][3];
          *(u32x2*)d = a; *(u32x2*)(d + 8) = bq;
        }
        __syncthreads();
        if (t4 + 1 < ntl) tload(t4 + 1);
        if ((w & 1) == 0 || nvalid == 64) attn_step_part(Ks, Vts, Qp, qf, o, m, l, r, hh, w & 1, w >> 1);
        __syncthreads();
      }
    }
  }
  {
    int t2 = threadIdx.x; asm volatile("" : "+v"(t2));
    const int w2 = t2 >> 6, ln2 = t2 & 63, r2 = ln2 & 31, h2 = (ln2 >> 5) & 1;
    const float lt = l + __shfl_xor(l, 32);
    float* cb = (float*)smem;
    __syncthreads();
    if (w2 & 1) {
      float* d = cb + (w2 >> 1) * 34 * 64 + ln2;
      d[0] = m; d[64] = lt;
#pragma unroll
      for (int d2 = 0; d2 < 2; ++d2)
#pragma unroll
        for (int i = 0; i < 16; ++i) d[(2 + d2 * 16 + i) * 64] = o[d2][i];
    }
    __syncthreads();
    if (!(w2 & 1)) {
      const float* d = cb + (w2 >> 1) * 34 * 64 + ln2;
      const float mB = d[0], lB = d[64];
      const float M = fmaxf(m, mB);
      const float fa = __builtin_amdgcn_exp2f(m - M), fb = __builtin_amdgcn_exp2f(mB - M);
      const float inv = 1.0f / (lt * fa + lB * fb);
      const int grow2 = RP + sb * 32 + r2;
#pragma unroll
      for (int d2 = 0; d2 < 2; ++d2)
#pragma unroll
        for (int gq = 0; gq < 4; ++gq) {
          float v[4];
#pragma unroll
          for (int e = 0; e < 4; ++e) v[e] = (o[d2][4 * gq + e] * fa + d[(2 + d2 * 16 + 4 * gq + e) * 64] * fb) * inv;
          u32x2 ov; ov[0] = pack2(v[0], v[1]); ov[1] = pack2(v[2], v[3]);
          *(u32x2*)(p.ao + (size_t)grow2 * 1024 + h * 128 + ((w2 >> 1) * 2 + d2) * 32 + 8 * gq + 4 * h2) = ov;
        }
    }
    __syncthreads();
  }
}

DI void phase_attn(const Params& p, char* smem, unsigned xcc) {
  int* sh = (int*)(smem + 76 * 1024 - 16);
  const int q0 = (int)(xcc & 7u);
  for (;;) {
    __syncthreads();
    if (threadIdx.x == 0) {
      int q = q0, li = 1 << 30;
      for (int d = 0; d < 8; ++d) {
        q = (q0 + d) & 7;
        li = atomicAdd(p.counter + q * 16, 1);
        if (li < 144) break;
      }
      sh[0] = li < 144 ? q * 256 + li : -1;
    }
    __syncthreads();
    const int code = sh[0];
    if (code < 0) break;
    const int q = code >> 8, li = code & 255;
    if (li < 16) { const int sb = 2 * q + (li >> 3), h = li & 7; attn_sample_item(p, smem, sb * 8 + h, sb, h); }
    else { const int desc = li >= 80 ? 1 : 0; const int bh = 2 * q + desc; attn_prompt_item(p, smem, bh >> 3, bh & 7, 63 - (li - 16 - 64 * desc), desc); }
  }
}

#define XB_TMO      128
#define XB_XCNT(j)  (256  + 64 * (j))
#define XB_XSUB(j)  (1280 + 64 * (j))
#define XB_XGEN(j)  (2304 + 64 * (j))
#define XB_TOP      3328
#define XB_TOPGEN   3392
#define XCD_BAR_WORDS 3456
#define XB_SPIN_CAP (1u << 20)
#define LAS __attribute__((address_space(3)))
DI unsigned xb_ld(unsigned* p)              { return __hip_atomic_load(p, __ATOMIC_RELAXED, __HIP_MEMORY_SCOPE_AGENT); }
DI unsigned xb_add(unsigned* p, unsigned v) { return __hip_atomic_fetch_add(p, v, __ATOMIC_RELAXED, __HIP_MEMORY_SCOPE_AGENT); }
DI unsigned xb_xcc_id() { return (unsigned)__builtin_amdgcn_s_getreg((3 << 11) | 20) & 0xFu; }
#define XB_SPIN(cond, bar) do { unsigned _sp = 0; while (cond) { __builtin_amdgcn_s_sleep(1); \
    if ((++_sp & 255u) == 0u) { if (xb_ld(&(bar)[XB_TMO])) break; if (_sp > XB_SPIN_CAP) { atomicAdd(&(bar)[XB_TMO], 1u); break; } } } } while (0)
struct XcdBarrier { unsigned* bar; unsigned x; volatile LAS unsigned* st; };
DI XcdBarrier xcd_barrier_post(unsigned* bar, volatile LAS unsigned* st) {
  XcdBarrier b; b.bar = bar; b.x = xb_xcc_id(); b.st = st;
  if (threadIdx.x == 0) (void)xb_add(&bar[XB_XCNT(b.x)], 1u);
  return b;
}
DI void xcd_barrier_complete(unsigned* bar, unsigned x, unsigned& nloc, unsigned& nx) {
  const unsigned G = gridDim.x * gridDim.y * gridDim.z;
  unsigned sum, cnt, mine, sp = 0u;
  for (;;) {
    sum = 0u; cnt = 0u; mine = 0u;
#pragma unroll
    for (unsigned j = 0; j < 16; ++j) { const unsigned c = xb_ld(&bar[XB_XCNT(j)]); sum += c; cnt += (c > 0u) ? 1u : 0u; mine = (j == x) ? c : mine; }
    if (sum == G) break;
    __builtin_amdgcn_s_sleep(1);
    if ((++sp & 255u) == 0u) { if (xb_ld(&bar[XB_TMO])) break; if (sp > XB_SPIN_CAP) { atomicAdd(&bar[XB_TMO], 1u); break; } }
  }
  nloc = mine > 0u ? mine : 1u; nx = cnt > 0u ? cnt : 1u;
}
DI void xcd_barrier(const XcdBarrier& b) {
  asm volatile("s_waitcnt vmcnt(0)" ::: "memory");
  __syncthreads();
  if (threadIdx.x == 0) {
    unsigned* bar = b.bar;
    __builtin_amdgcn_s_waitcnt(0);
    unsigned nloc = b.st[0], nx = b.st[1];
    if (nloc == 0u) { xcd_barrier_complete(bar, b.x, nloc, nx); b.st[0] = nloc; b.st[1] = nx; }
    const unsigned old = xb_add(&bar[XB_XSUB(b.x)], 1u);
    const unsigned gen = old / nloc;
    if (old + 1u == (gen + 1u) * nloc) {
      __builtin_amdgcn_fence(__ATOMIC_RELEASE, "agent");
      asm volatile("s_waitcnt vmcnt(0)" ::: "memory");
      const unsigned og = xb_add(&bar[XB_TOP], 1u);
      const unsigned tg = og / nx;
      if (og + 1u == (tg + 1u) * nx) xb_add(&bar[XB_TOPGEN], 1u);
      else XB_SPIN(xb_ld(&bar[XB_TOPGEN]) == tg, bar);
      __builtin_amdgcn_fence(__ATOMIC_ACQUIRE, "agent");
      xb_add(&bar[XB_XGEN(b.x)], 1u);
      asm volatile("s_waitcnt vmcnt(0)" ::: "memory");
    } else {
      XB_SPIN(xb_ld(&bar[XB_XGEN(b.x)]) == gen, bar);
      __builtin_amdgcn_fence(__ATOMIC_ACQUIRE, "agent");
      asm volatile("s_waitcnt vmcnt(0)" ::: "memory");
    }
  }
  __syncthreads();
}

__global__ void __launch_bounds__(256, 2) yoco_megakernel(const Params p, int ph0, int ph1) {
  extern __shared__ __attribute__((aligned(16))) char smem[];
  const int bid = blockIdx.x, G = gridDim.x;
  __shared__ uint4 xb_words;
  if (threadIdx.x == 0) xb_words = make_uint4(0u, 0u, 0u, 0u);
  __syncthreads();
  (void)xcd_barrier_post(p.bar, (volatile LAS unsigned*)&xb_words);
#define XBH (XcdBarrier{p.bar, xb_xcc_id(), (volatile LAS unsigned*)&xb_words})
  if (ph0 == 12345) cg::this_grid().sync();
#define PH_BEGIN(n) if (EN(n) && ph0 <= (n) && (n) < ph1) {
#define PH_END(n) } if (ph0 <= (n) && (n) + 1 < ph1) { const XcdBarrier xbb = XBH; xcd_barrier(xbb); }
  PH_BEGIN(0) phase_prep(p, smem); PH_END(0)
  PH_BEGIN(1) { GemmDesc g{p.xb, DM, p.Wgla_in, DM, DM, 132, 25, EPI_GLA_IN, 0, nullptr, nullptr, nullptr, 0, 1, 1}; gemm_phase(p, g, smem, 0, xb_xcc_id()); } PH_END(1)
  PH_BEGIN(2) phase_gla_a(p, smem); PH_END(2)
  PH_BEGIN(3) phase_gla_scan(p); PH_END(3)
  PH_BEGIN(4) phase_gla_c(p, smem); PH_END(4)
  PH_BEGIN(5) { GemmDesc g{p.Rg, DM, p.Wgla_out, DM, DM, 132, 8, EPI_RESID, 0, p.in[0], p.in[1], p.out + O_Y, 1, 0, 1}; gemm_phase(p, g, smem, 1, xb_xcc_id()); } PH_END(5)
  PH_BEGIN(6) { GemmDesc g{p.xb, DM, p.Wffn_in[0], DM, DM, 132, 44, EPI_FFN_IN, 0, nullptr, nullptr, nullptr, 0, 8, 12}; gemm_phase(p, g, smem, 2, xb_xcc_id()); } PH_END(6)
  PH_BEGIN(7) { GemmDesc g{p.act, DFF, p.Wffn_out[0], DFF, DFF, 132, 8, EPI_RESID, 0, p.out + O_Y, p.out + O_Y + (size_t)RP * DM, p.out + O_Y, 1, 0, 1}; gemm_phase(p, g, smem, 3, xb_xcc_id()); } PH_END(7)
  PH_BEGIN(8) { GemmDesc g{p.xb, DM, p.Wdkvq, DM, DM, 132, 7, EPI_DKVQ, 0, nullptr, nullptr, nullptr, 0, 8, 1}; gemm_phase(p, g, smem, 4, xb_xcc_id()); } PH_END(8)
  PH_BEGIN(9) phase_e2(p); PH_END(9)
  PH_BEGIN(10) {
    { GemmDesc g{p.ACKVp, 256, p.Wukv, 256, 256, 128, 16, EPI_UKV, 0, nullptr, nullptr, nullptr, 0, 0, 1}; gemm_phase(p, g, smem, 5, xb_xcc_id()); }
    const int n1 = 128 * 16;
    { GemmDesc g{p.CQN, 512, p.Wuq, 512, 512, 132, 12, EPI_UQ, 0, nullptr, nullptr, nullptr, 0, 0, 1}; gemm_phase(p, g, smem, 6, xb_xcc_id()); }
  } PH_END(10)
  PH_BEGIN(11) phase_attn(p, smem, xb_xcc_id()); PH_END(11)
  PH_BEGIN(12) { GemmDesc g{p.ao, DM, p.Wmla_out, DM, DM, 132, 8, EPI_RESID, 0, p.out + O_Y, p.out + O_Y + (size_t)RP * DM, p.out + O_Y, 1, 0, 1}; gemm_phase(p, g, smem, 7, xb_xcc_id()); } PH_END(12)
  PH_BEGIN(13) { GemmDesc g{p.xb, DM, p.Wffn_in[1], DM, DM, 132, 44, EPI_FFN_IN, 1, nullptr, nullptr, nullptr, 0, 8, 12}; gemm_phase(p, g, smem, 8, xb_xcc_id()); } PH_END(13)
  PH_BEGIN(14) { GemmDesc g{p.act, DFF, p.Wffn_out[1], DFF, DFF, 132, 8, EPI_RESID, 1, p.out + O_Y, p.out + O_Y + (size_t)RP * DM, p.out + O_Y, 0, 0, 1}; gemm_phase(p, g, smem, 9, xb_xcc_id()); }
  }
}

static inline size_t al(size_t x) { return (x + 255) & ~(size_t)255; }

extern "C" void kernel_launch(void* const* d_in, const int* in_sizes, int n_in, void* d_out, int out_size, void* d_ws, size_t ws_size, hipStream_t stream) {
  Params p;
  memset(&p, 0, sizeof(p));
  for (int i = 0; i < 30; ++i) p.in[i] = (const float*)d_in[i];
  p.out = (float*)d_out;
  char* ws = (char*)d_ws; size_t off = 0;
  auto take = [&](size_t bytes) { char* q = ws + off; off = al(off + bytes); return q; };
  p.Wgla_in = (u16*)take((size_t)3200 * 1024 * 2);
  p.Wgla_out = (u16*)take((size_t)1024 * 1024 * 2);
  for (int l = 0; l < 2; ++l) p.Wffn_in[l] = (u16*)take((size_t)5632 * 1024 * 2);
  for (int l = 0; l < 2; ++l) p.Wffn_out[l] = (u16*)take((size_t)1024 * 2816 * 2);
  p.Wdkvq = (u16*)take((size_t)896 * 1024 * 2);
  p.Wukv = (u16*)take((size_t)2048 * 256 * 2);
  p.Wuq = (u16*)take((size_t)1536 * 512 * 2);
  p.Wmla_out = (u16*)take((size_t)1024 * 1024 * 2);
  p.rsp = (float*)take((size_t)8 * R * 4);
  p.counter = (int*)take(8192);
  p.bar = (unsigned*)take(XCD_BAR_WORDS * 4);
  p.xb = (u16*)take((size_t)R * 1024 * 2 + 65536);
  p.ACKVs = p.xb;
  const size_t regionA = off;
  p.Rg = (u16*)take((size_t)R * 1024 * 2);
  p.Vt = (u16*)take((size_t)1024 * R * 2 + 4096);
  p.US = (u16*)take((size_t)NSLOT * 32768 * 2);
  p.dec = (float*)take((size_t)NSLOT * 128 * 4);
  size_t maxoff = off;
  p.Qg = (u16*)d_out;
  p.Kg = p.Qg + (size_t)R * 512;
  p.GA = (float*)(p.Kg + (size_t)R * 512);
  off = regionA;
  p.act = (u16*)take((size_t)R * DFF * 2);
  if (off > maxoff) maxoff = off;
  off = regionA;
  p.CQN = (u16*)take((size_t)R * 512 * 2);
  p.ACKVp = (u16*)take((size_t)RP * 256 * 2);
  p.AKPEp = p.Wffn_in[0];
  p.AKPEs = p.Wffn_in[0] + (size_t)RP * 64 + 128;
  p.Knp = (u16*)take((size_t)16 * 8192 * 128 * 2);
  p.Vtp = (u16*)take((size_t)16 * 128 * 8192 * 2);
  p.Qb = (u16*)take((size_t)R * 1536 * 2);
  p.ao = (u16*)take((size_t)R * 1024 * 2);
  p.RAW = (float*)p.Knp;
  if (off > maxoff) maxoff = off;
  if (maxoff > ws_size) { fprintf(stderr, "workspace too small: need %zu have %zu\n", maxoff, ws_size); return; }

  int t0 = 0, nj = 0;
  auto addj = [&](const float* src, const float* gain, u16* dst, int ld, int K, int nblk, int kind, int ncols) {
    WJob& j = p.wj[nj++]; j.src = src; j.gain = gain; j.dst = dst; j.ld = ld; j.K = K; j.nblk = nblk; j.kind = kind; j.ncols = ncols; j.tile0 = t0; t0 += nblk * (K / 64);
  };
  const float* nm = p.in[6]; const float* nf = p.in[7];
  addj(p.in[12], nm, p.Wgla_in, 3072, 1024, 48, 0, 64);
  addj(p.in[13], nm, p.Wgla_in + (size_t)3072 * 1024, 16, 1024, 1, 1, 16);
  addj(p.in[13], nm, p.Wgla_in + (size_t)3136 * 1024, 16, 1024, 1, 1, 0);
  addj(p.in[17], nullptr, p.Wgla_out, 1024, 1024, 16, 0, 64);
  addj(p.in[8], nf, p.Wffn_in[0], 5632, 1024, 88, 2, 64);
  addj(p.in[8] + (size_t)1024 * 5632, nf + 1024, p.Wffn_in[1], 5632, 1024, 88, 2, 64);
  addj(p.in[11], nullptr, p.Wffn_out[0], 1024, 2816, 16, 0, 64);
  addj(p.in[11] + (size_t)2816 * 1024, nullptr, p.Wffn_out[1], 1024, 2816, 16, 0, 64);
  addj(p.in[25], p.in[24], p.Wdkvq, 320, 1024, 5, 0, 64);
  addj(p.in[25], p.in[24], p.Wdkvq + (size_t)320 * 1024, 320, 1024, 1, 1, 0);
  addj(p.in[18], nm + 1024, p.Wdkvq + (size_t)384 * 1024, 512, 1024, 8, 0, 64);
  addj(p.in[27], nullptr, p.Wukv, 2048, 256, 32, 0, 64);
  addj(p.in[20], nullptr, p.Wuq, 1536, 512, 24, 4, 64);
  addj(p.in[23], nullptr, p.Wmla_out, 1024, 1024, 16, 0, 64);
  p.n_wtiles = t0;

  (void)hipFuncSetAttribute((const void*)yoco_megakernel, hipFuncAttributeMaxDynamicSharedMemorySize, LDS_BYTES);
  int dev = 0, cus = 0, per_cu = 0;
  (void)hipGetDevice(&dev);
  (void)hipDeviceGetAttribute(&cus, hipDeviceAttributeMultiprocessorCount, dev);
  (void)hipOccupancyMaxActiveBlocksPerMultiprocessor(&per_cu, yoco_megakernel, 256, LDS_BYTES);
  if (per_cu < 1) per_cu = 1;
  if (per_cu > 2) per_cu = 2;
  const int grid = cus * per_cu;
#if MULTI_LAUNCH
  for (int ph = 0; ph < NPH; ++ph) hipLaunchKernelGGL(yoco_megakernel, dim3(grid), dim3(256), LDS_BYTES, stream, p, ph, ph + 1);
#else
  (void)hipMemsetAsync(p.bar, 0, XCD_BAR_WORDS * 4, stream);
  int ph0 = 0, ph1 = NPH;
  void* args[] = {(void*)&p, (void*)&ph0, (void*)&ph1};
  hipError_t e = hipLaunchCooperativeKernel((const void*)yoco_megakernel, dim3(grid), dim3(256), args, LDS_BYTES, stream);
  if (e != hipSuccess) fprintf(stderr, "cooperative launch failed: %s (grid %d)\n", hipGetErrorString(e), grid);
#endif
}
```

```cpp
#include <hip/hip_runtime.h>
#include <hip/hip_cooperative_groups.h>
#include <cstdio>
#include <cstdint>
#include <cstring>
namespace cg = cooperative_groups;

#ifndef MULTI_LAUNCH
#define MULTI_LAUNCH 0
#endif

#ifndef PHMASK
#define PHMASK 0x7fff
#endif
#define EN(n) ((PHMASK >> (n)) & 1)
#define DI __device__ __forceinline__
typedef unsigned short u16;
using bf16x8 = __attribute__((ext_vector_type(8))) short;
using s16x4  = __attribute__((ext_vector_type(4))) short;
using f32x16 = __attribute__((ext_vector_type(16))) float;
using u32x4  = __attribute__((ext_vector_type(4))) unsigned;
using u32x2  = __attribute__((ext_vector_type(2))) unsigned;
#define MFMA(a, b, c) __builtin_amdgcn_mfma_f32_32x32x16_bf16((a), (b), (c), 0, 0, 0)

constexpr int R = 16896;
constexpr int RP = 16384;
constexpr int DM = 1024;
constexpr int DFF = 2816;
constexpr int TS = 4128;
constexpr float EPS = 1e-6f;
constexpr int NSLOT = 1088;
constexpr int LDS_BYTES = 77824;
constexpr int NPH = 15;

constexpr size_t O_Y = 0;
constexpr size_t O_GLAP = 17301504;
constexpr size_t O_FFNP = 17563648;
constexpr size_t O_CKVP = 17586176;
constexpr size_t O_KPEP = 21780480;
constexpr size_t O_GLAS = 22829056;
constexpr size_t O_FFNS = 24926208;
constexpr size_t O_CKVS = 25106432;
constexpr size_t O_KPES = 25237504;

struct WJob { const float* src; const float* gain; u16* dst; int ld; int K; int nblk; int kind; int ncols; int tile0; };
constexpr int NWJ = 14;

struct Params {
  const float* in[30];
  float* out;
  u16 *Wgla_in, *Wgla_out, *Wffn_in[2], *Wffn_out[2], *Wdkvq, *Wukv, *Wuq, *Wmla_out;
  u16* xb; float* rsp;
  u16 *Qg, *Kg; float* GA; u16 *Rg, *Vt, *US; float* dec;
  u16* act;
  float* RAW; u16 *CQN, *ACKVp, *ACKVs, *AKPEp, *AKPEs, *Knp, *Vtp, *Qb, *ao;
  int* counter; unsigned* bar;
  WJob wj[NWJ];
  int n_wtiles; int pad0;
};

typedef __bf16 bf2_t __attribute__((ext_vector_type(2)));
typedef float f2_t __attribute__((ext_vector_type(2)));
DI u16 f2bf(float x) { return __builtin_bit_cast(u16, (__bf16)x); }
DI float bf2f(u16 h) { return __uint_as_float(((unsigned)h) << 16); }
DI unsigned pack2(float a, float b) { f2_t v; v[0] = a; v[1] = b; return __builtin_bit_cast(unsigned, __builtin_convertvector(v, bf2_t)); }
DI float bflo(unsigned u) { return __uint_as_float(u << 16); }
DI float bfhi(unsigned u) { return __uint_as_float(u & 0xffff0000u); }
DI int crow(int reg, int h) { return (reg & 3) + 8 * (reg >> 2) + 4 * h; }
DI bf16x8 pack8(const f32x16& x, int s) {
  u32x4 p;
  p[0] = pack2(x[8 * s + 0], x[8 * s + 1]); p[1] = pack2(x[8 * s + 2], x[8 * s + 3]);
  p[2] = pack2(x[8 * s + 4], x[8 * s + 5]); p[3] = pack2(x[8 * s + 6], x[8 * s + 7]);
  return __builtin_bit_cast(bf16x8, p);
}
DI f32x16 zero16() { f32x16 z; for (int i = 0; i < 16; ++i) z[i] = 0.f; return z; }
DI float rowscale(const float* rsp, int np, int row) {
  float s = 0.f; for (int p = 0; p < np; ++p) s += rsp[(size_t)p * R + row];
  return rsqrtf(s * (1.0f / 1024.0f) + EPS);
}
DI int row_pos(int row) { return row < RP ? (row & 8191) : 4096 + ((row - RP) & 31); }

DI void prep_wtile(const Params& p, int j, char* smem) {
  int mi = 0;
  for (int i = 1; i < NWJ; ++i) if (j >= p.wj[i].tile0) mi = i;
  const WJob wj = p.wj[mi];
  const int local = j - wj.tile0, nkt = wj.K >> 6;
  const int blk = local / nkt, kt = local - blk * nkt, k0 = kt << 6;
  int col0 = blk * 64, ncols = 64;
  if (wj.kind == 1) { col0 = 0; ncols = wj.ncols; }
  else if (wj.kind == 2) { col0 = (blk & 1) * DFF + 64 * (blk >> 1); }
  else if (wj.kind == 4) { col0 = blk < 16 ? (blk >> 1) * 192 + 64 * (blk & 1) : (blk - 16) * 192 + 128; }
  float* T = (float*)smem;
  const int tid = threadIdx.x;
  {
    const int jc = tid & 63, i0 = tid >> 6;
    float vv[16], gg[16];
    const bool ok = jc < ncols;
    const float* sp = wj.src + (size_t)(k0 + i0) * wj.ld + col0 + jc;
#pragma unroll
    for (int ii = 0; ii < 16; ++ii) {
      vv[ii] = ok ? sp[(size_t)(4 * ii) * wj.ld] : 0.f;
      gg[ii] = wj.gain ? wj.gain[k0 + i0 + 4 * ii] : 1.0f;
    }
#pragma unroll
    for (int ii = 0; ii < 16; ++ii) T[(i0 + 4 * ii) * 65 + jc] = vv[ii] * gg[ii];
  }
  __syncthreads();
  {
    const int jr = tid >> 2, iseg = tid & 3;
    unsigned pk[8];
    for (int q = 0; q < 8; ++q) pk[q] = pack2(T[(iseg * 16 + 2 * q) * 65 + jr], T[(iseg * 16 + 2 * q + 1) * 65 + jr]);
    u16* d = wj.dst + (size_t)(blk * 64 + jr) * wj.K + k0 + iseg * 16;
    u32x4 a, b; a[0] = pk[0]; a[1] = pk[1]; a[2] = pk[2]; a[3] = pk[3]; b[0] = pk[4]; b[1] = pk[5]; b[2] = pk[6]; b[3] = pk[7];
    *(u32x4*)d = a; *(u32x4*)(d + 8) = b;
  }
  __syncthreads();
}

DI void phase_prep(const Params& p, char* smem) {
  const int tid = threadIdx.x, lane = tid & 63, w = tid >> 6;
  if (blockIdx.x == 0) { for (int i = tid; i < 2048; i += 256) p.counter[i] = 0; }
  const int nW = p.n_wtiles, nX = R / 4;
  for (int j = blockIdx.x; j < nW + nX; j += gridDim.x) {
    if (j < nW) { prep_wtile(p, j, smem); continue; }
    const int row = (j - nW) * 4 + w;
    const float* x = row < RP ? p.in[0] + (size_t)row * DM : p.in[1] + (size_t)(row - RP) * DM;
    float ss = 0.f;
    float4 xv[4];
#pragma unroll
    for (int i = 0; i < 4; ++i) xv[i] = *(const float4*)(x + lane * 4 + 256 * i);
#pragma unroll
    for (int i = 0; i < 4; ++i) {
      const float4 v = xv[i];
      ss += v.x * v.x + v.y * v.y + v.z * v.z + v.w * v.w;
      u32x2 o; o[0] = pack2(v.x, v.y); o[1] = pack2(v.z, v.w);
      *(u32x2*)(p.xb + (size_t)row * DM + lane * 4 + 256 * i) = o;
    }
    for (int m = 1; m < 64; m <<= 1) ss += __shfl_xor(ss, m);
    if (lane == 0) p.rsp[row] = ss;
  }
}

constexpr int GSTAGE = 256 * 144;
template <int NS>
DI void gemm_main_t(const u16* __restrict__ Ab, int lda, const u16* __restrict__ Bb, int ldb, int K, char* smem, f32x16 (&acc)[2][2]) {
  int tid = threadIdx.x; asm volatile("" : "+v"(tid));
  const int lane = tid & 63, w = tid >> 6, r = lane & 31, hh = lane >> 5;
  const int wm = w >> 1, wn = w & 1;
  const int lrow = tid >> 3, lkc = tid & 7;
  const unsigned aoff = (unsigned)(lrow * lda + lkc * 8), boff = (unsigned)(lrow * ldb + lkc * 8);
  const unsigned lso = (unsigned)(lrow * 144 + lkc * 16);
  u32x4 ra[NS][4], rb[NS][4];
  for (int tm = 0; tm < 2; ++tm) for (int tn = 0; tn < 2; ++tn) acc[tm][tn] = zero16();
  const int nk = K >> 6;
#define G_LOAD(set, kt_) { const u16* a_ = Ab + (size_t)(kt_) * 64; const u16* b_ = Bb + (size_t)(kt_) * 64; \
    _Pragma("unroll") for (int i = 0; i < 4; ++i) { ra[set][i] = *(const u32x4*)(a_ + (size_t)(32 * i) * lda + aoff); rb[set][i] = *(const u32x4*)(b_ + (size_t)(32 * i) * ldb + boff); } }
#define G_STORE(set, st_) { char* d_ = smem + (st_) * GSTAGE + lso; \
    _Pragma("unroll") for (int i = 0; i < 4; ++i) { *(u32x4*)(d_ + 32 * i * 144) = ra[set][i]; *(u32x4*)(d_ + 128 * 144 + 32 * i * 144) = rb[set][i]; } }
#define G_COMPUTE(st_) { const char* sa = smem + (st_) * GSTAGE; const char* sb = sa + 128 * 144; \
    _Pragma("unroll") for (int ks = 0; ks < 4; ++ks) { bf16x8 af[2], bfr[2]; \
      _Pragma("unroll") for (int t = 0; t < 2; ++t) { \
        af[t] = *(const bf16x8*)(sa + (wm * 64 + t * 32 + r) * 144 + (ks * 16 + hh * 8) * 2); \
        bfr[t] = *(const bf16x8*)(sb + (wn * 64 + t * 32 + r) * 144 + (ks * 16 + hh * 8) * 2); } \
      _Pragma("unroll") for (int tm = 0; tm < 2; ++tm) _Pragma("unroll") for (int tn = 0; tn < 2; ++tn) acc[tm][tn] = MFMA(af[tm], bfr[tn], acc[tm][tn]); } }
#define G_COMPUTE_ST(st_, set, sst_, dost, lset, lkt_, dold) { const char* sa = smem + (st_) * GSTAGE; const char* sb = sa + 128 * 144; char* d_ = smem + (sst_) * GSTAGE + lso; \
    const u16* a_ = Ab + (size_t)(lkt_) * 64; const u16* b_ = Bb + (size_t)(lkt_) * 64; \
    _Pragma("unroll") for (int ks = 0; ks < 4; ++ks) { bf16x8 af[2], bfr[2]; \
      _Pragma("unroll") for (int t = 0; t < 2; ++t) { \
        af[t] = *(const bf16x8*)(sa + (wm * 64 + t * 32 + r) * 144 + (ks * 16 + hh * 8) * 2); \
        bfr[t] = *(const bf16x8*)(sb + (wn * 64 + t * 32 + r) * 144 + (ks * 16 + hh * 8) * 2); } \
      acc[0][0] = MFMA(af[0], bfr[0], acc[0][0]); acc[0][1] = MFMA(af[0], bfr[1], acc[0][1]); \
      if (dost) { *(u32x4*)(d_ + 32 * ks * 144) = ra[set][ks]; } \
      if (dold) { ra[lset][ks] = *(const u32x4*)(a_ + (size_t)(32 * ks) * lda + aoff); } \
      acc[1][0] = MFMA(af[1], bfr[0], acc[1][0]); acc[1][1] = MFMA(af[1], bfr[1], acc[1][1]); \
      if (dost) { *(u32x4*)(d_ + 128 * 144 + 32 * ks * 144) = rb[set][ks]; } \
      if (dold) { rb[lset][ks] = *(const u32x4*)(b_ + (size_t)(32 * ks) * ldb + boff); } } }
#define G_ITER(j) { const int i_ = kt + (j); if (i_ < nk) { \
      G_COMPUTE_ST(i_ & 1, ((j) + 1) % NS, (i_ + 1) & 1, (i_ + 1 < nk), j, i_ + NS, (i_ + NS < nk)) \
      __syncthreads(); } }
  G_LOAD(0, 0)
  if (1 < nk) G_LOAD(1, 1)
  if (NS > 2) { if (2 < nk) G_LOAD(NS > 2 ? 2 : 0, 2) }
  G_STORE(0, 0)
  __syncthreads();
  for (int kt = 0; kt < nk; kt += NS) { G_ITER(0) G_ITER(1) if (NS > 2) G_ITER(NS > 2 ? 2 : 0) }
#undef G_LOAD
#undef G_STORE
#undef G_COMPUTE
#undef G_COMPUTE_ST
#undef G_ITER
  float* Cs = (float*)smem;
#pragma unroll
  for (int tm = 0; tm < 2; ++tm)
#pragma unroll
    for (int tn = 0; tn < 2; ++tn)
#pragma unroll
      for (int i = 0; i < 16; ++i)
        Cs[(wm * 64 + tm * 32 + crow(i, hh)) * 132 + wn * 64 + tn * 32 + r] = acc[tm][tn][i];
  __syncthreads();
}

DI void gemm_main32(const u16* __restrict__ Ab, int lda, const u16* __restrict__ Bb, int ldb, int K, char* smem, f32x16& acc) {
  int tid = threadIdx.x; asm volatile("" : "+v"(tid));
  const int lane = tid & 63, w = tid >> 6, r = lane & 31, hh = lane >> 5;
  const int lrow = tid >> 3, lkc = tid & 7;
  const unsigned aoff = (unsigned)(lrow * lda + lkc * 8), boff = (unsigned)(lrow * ldb + lkc * 8);
  const unsigned lso = (unsigned)(lrow * 144 + lkc * 16);
  u32x4 ra[3], rb[3][4];
  acc = zero16();
  const int nk = K >> 6;
#define H_LOAD(set, kt_) { const u16* a_ = Ab + (size_t)(kt_) * 64; const u16* b_ = Bb + (size_t)(kt_) * 64; ra[set] = *(const u32x4*)(a_ + aoff); \
    _Pragma("unroll") for (int i = 0; i < 4; ++i) rb[set][i] = *(const u32x4*)(b_ + (size_t)(32 * i) * ldb + boff); }
#define H_STORE(set, st_) { char* d_ = smem + (st_) * GSTAGE + lso; *(u32x4*)d_ = ra[set]; \
    _Pragma("unroll") for (int i = 0; i < 4; ++i) *(u32x4*)(d_ + 128 * 144 + 32 * i * 144) = rb[set][i]; }
#define H_COMPUTE(st_) { const char* sa = smem + (st_) * GSTAGE; const char* sb = sa + 128 * 144; \
    _Pragma("unroll") for (int ks = 0; ks < 4; ++ks) { \
      const bf16x8 af = *(const bf16x8*)(sa + r * 144 + (ks * 16 + hh * 8) * 2); \
      const bf16x8 bq = *(const bf16x8*)(sb + (w * 32 + r) * 144 + (ks * 16 + hh * 8) * 2); \
      acc = MFMA(af, bq, acc); } }
#define H_ITER(j) { const int i_ = kt + (j); if (i_ < nk) { \
      if (i_ + 3 < nk) H_LOAD(j, i_ + 3) \
      H_COMPUTE(i_ & 1) \
      if (i_ + 1 < nk) H_STORE(((j) + 1) % 3, (i_ + 1) & 1) \
      __syncthreads(); } }
  H_LOAD(0, 0)
  if (1 < nk) H_LOAD(1, 1)
  if (2 < nk) H_LOAD(2, 2)
  H_STORE(0, 0)
  __syncthreads();
  for (int kt = 0; kt < nk; kt += 3) { H_ITER(0) H_ITER(1) H_ITER(2) }
#undef H_LOAD
#undef H_STORE
#undef H_COMPUTE
#undef H_ITER
  float* Cs = (float*)smem;
#pragma unroll
  for (int i = 0; i < 16; ++i) Cs[crow(i, hh) * 132 + w * 32 + r] = acc[i];
  __syncthreads();
}

DI void gemm_main(const u16* __restrict__ Ab, int lda, const u16* __restrict__ Bb, int ldb, int K, char* smem, f32x16 (&acc)[2][2]) { gemm_main_t<3>(Ab, lda, Bb, ldb, K, smem, acc); }

DI void gemm_small256(const u16* __restrict__ Ab, int lda, const u16* __restrict__ Bb, int ldb, char* smem, f32x16 (&acc)[2][2]) {
  int tid = threadIdx.x; asm volatile("" : "+v"(tid));
  const int lane = tid & 63, w = tid >> 6, r = lane & 31, hh = lane >> 5;
  const int wm = w >> 1, wn = w & 1;
  const int lrow = tid >> 3, lkc = tid & 7;
  const unsigned aoff = (unsigned)(lrow * lda + lkc * 8), boff = (unsigned)(lrow * ldb + lkc * 8);
  const unsigned lso = (unsigned)(lrow * 144 + lkc * 16);
  u32x4 ra[4], rb[4];
  for (int tm = 0; tm < 2; ++tm) for (int tn = 0; tn < 2; ++tn) acc[tm][tn] = zero16();
#pragma unroll
  for (int i = 0; i < 4; ++i) { ra[i] = *(const u32x4*)(Ab + (size_t)(32 * i) * lda + aoff); rb[i] = *(const u32x4*)(Bb + (size_t)(32 * i) * ldb + boff); }
#pragma unroll
  for (int i = 0; i < 4; ++i) { *(u32x4*)(smem + lso + 32 * i * 144) = ra[i]; *(u32x4*)(smem + 128 * 144 + lso + 32 * i * 144) = rb[i]; }
  __syncthreads();
#pragma unroll 1
  for (int kt = 0; kt < 4; ++kt) {
    const bool more = kt + 1 < 4;
    if (more) {
      const int k0 = (kt + 1) << 6;
#pragma unroll
      for (int i = 0; i < 4; ++i) { ra[i] = *(const u32x4*)(Ab + (size_t)(32 * i) * lda + aoff + k0); rb[i] = *(const u32x4*)(Bb + (size_t)(32 * i) * ldb + boff + k0); }
    }
    const char* sa = smem + (kt & 1) * GSTAGE; const char* sb = sa + 128 * 144;
#pragma unroll
    for (int ks = 0; ks < 4; ++ks) {
      bf16x8 af[2], bfr[2];
#pragma unroll
      for (int t = 0; t < 2; ++t) {
        af[t] = *(const bf16x8*)(sa + (wm * 64 + t * 32 + r) * 144 + (ks * 16 + hh * 8) * 2);
        bfr[t] = *(const bf16x8*)(sb + (wn * 64 + t * 32 + r) * 144 + (ks * 16 + hh * 8) * 2);
      }
#pragma unroll
      for (int tm = 0; tm < 2; ++tm)
#pragma unroll
        for (int tn = 0; tn < 2; ++tn) acc[tm][tn] = MFMA(af[tm], bfr[tn], acc[tm][tn]);
    }
    if (more) {
      char* da = smem + ((kt + 1) & 1) * GSTAGE + lso;
#pragma unroll
      for (int i = 0; i < 4; ++i) { *(u32x4*)(da + 32 * i * 144) = ra[i]; *(u32x4*)(da + 128 * 144 + 32 * i * 144) = rb[i]; }
    }
    __syncthreads();
  }
  float* Cs = (float*)smem;
#pragma unroll
  for (int tm = 0; tm < 2; ++tm)
#pragma unroll
    for (int tn = 0; tn < 2; ++tn)
#pragma unroll
      for (int i = 0; i < 16; ++i)
        Cs[(wm * 64 + tm * 32 + crow(i, hh)) * 132 + wn * 64 + tn * 32 + r] = acc[tm][tn][i];
  __syncthreads();
}

enum { EPI_GLA_IN = 0, EPI_RESID, EPI_FFN_IN, EPI_DKVQ, EPI_UKV, EPI_UQ };

struct GemmDesc {
  const u16* A; int lda; const u16* B; int ldb; int K; int MT; int NT; int epi; int layer;
  const float* xin_p; const float* xin_s; float* xout; int write_xb; int np; int seglen;
};

DI float gelu_exact(float x) { return 0.5f * x * (1.0f + erff(x * 0.70710678118654752f)); }

DI void gemm_phase(const Params& p, const GemmDesc& g, char* smem, int blk0, unsigned xcc) {
  float* Cs = (float*)smem;
  float* rsS = (float*)(smem + 67584);
  float* Hs = rsS + 136;
  float* Hp = Hs + 128;
  float* Hc = (float*)(smem + 73728);
  float* xh = (float*)(smem + 69632);
  const int nseg = (g.MT + g.seglen - 1) / g.seglen;
  int* jsh = (int*)(smem + 76 * 1024 - 16);
  int* ctr = p.counter + 256 + blk0 * 128;
  const int q0 = (int)(xcc & 7u);
  for (;;) {
   __syncthreads();
   if (threadIdx.x == 0) {
     int code = -1;
     int qq = q0; asm volatile("" : "+v"(qq));
     for (int d = 0; d < 8; ++d) {
       const int q = (qq + d) & 7;
       if (g.NT <= 8 && g.seglen == 1) {
         const int mlo = (q * g.MT) >> 3, mhi = ((q + 1) * g.MT) >> 3;
         const int li = atomicAdd(ctr + q * 16, 1);
         const bool sliced = (g.epi == EPI_RESID) && (mhi - mlo == 17);
         const int nfull = sliced ? 16 : (mhi - mlo);
         if (li < nfull * g.NT) { const int mm = li / g.NT; code = (mlo + mm) * 64 + (li - mm * g.NT); break; }
         if (sliced && li < nfull * g.NT + 4 * g.NT) { const int s2 = li - nfull * g.NT; const int sl = s2 / g.NT; code = ((sl + 1) << 20) + (mlo + 16) * 64 + (s2 - sl * g.NT); break; }
         continue;
       }
       const int lo = (q * g.NT) >> 3, hi = ((q + 1) * g.NT) >> 3, ntq = hi - lo;
       if (ntq <= 0) continue;
       const int li = atomicAdd(ctr + q * 16, 1);
       if (li < ntq * nseg) { const int sg = (int)(((float)li + 0.5f) / (float)ntq); code = sg * 64 + lo + (li - sg * ntq); break; }
     }
     jsh[0] = code;
   }
   __syncthreads();
   const int code = jsh[0];
   if (code < 0) break;
   const int nt = code & 63, seg = (code >> 6) & 0x3fff, slc = code >> 20;
   const int mt_end = (seg + 1) * g.seglen < g.MT ? (seg + 1) * g.seglen : g.MT;
   for (int mt = seg * g.seglen; mt < mt_end; ++mt) {
    const bool carried = mt > seg * g.seglen;
    const int m0 = mt * 128 + (slc ? (slc - 1) * 32 : 0), n0 = nt * 128;
    const int ritn = slc ? 4 : 16;
    bool swap = false;
    if (g.epi == EPI_GLA_IN) swap = (nt >= 8 && nt < 16);
    if (g.epi == EPI_UKV) swap = (nt & 1);
    const u16* Ap = g.A + (size_t)m0 * g.lda;
    const u16* Bp = g.B + (size_t)n0 * g.ldb;
    if (g.epi == EPI_RESID && slc) { f32x16 acc1; gemm_main32(Ap, g.lda, Bp, g.ldb, g.K, smem, acc1); }
    else {
      f32x16 acc[2][2];
      if (swap) gemm_main(Bp, g.ldb, Ap, g.lda, g.K, smem, acc);
      else gemm_main(Ap, g.lda, Bp, g.ldb, g.K, smem, acc);
    }
    int tid = threadIdx.x; asm volatile("" : "+v"(tid));
    const int lane = tid & 63;
    if (g.epi == EPI_GLA_IN) {
      if (tid < 128) rsS[tid] = rowscale(p.rsp, 1, m0 + tid);
      __syncthreads();
      for (int it = 0; it < 16; ++it) {
        const int idx = tid + 256 * it, row = idx >> 5, c4 = (idx & 31) * 4;
        float4 v = *(const float4*)&Cs[row * 132 + c4];
        if (swap) {
          u32x2 o; o[0] = pack2(v.x * rsS[c4], v.y * rsS[c4 + 1]); o[1] = pack2(v.z * rsS[c4 + 2], v.w * rsS[c4 + 3]);
          *(u32x2*)(p.Vt + (size_t)((nt - 8) * 128 + row) * R + m0 + c4) = o;
        } else {
          const float rs = rsS[row];
          if (nt < 4) {
            const float s = rs * 0.08838834764831845f;
            u32x2 o; o[0] = pack2(v.x * s, v.y * s); o[1] = pack2(v.z * s, v.w * s);
            *(u32x2*)(p.Qg + (size_t)(m0 + row) * 512 + n0 + c4) = o;
          } else if (nt < 8) {
            u32x2 o; o[0] = pack2(v.x * rs, v.y * rs); o[1] = pack2(v.z * rs, v.w * rs);
            *(u32x2*)(p.Kg + (size_t)(m0 + row) * 512 + (n0 - 512) + c4) = o;
          } else if (nt < 24) {
            u32x2 o; o[0] = pack2(v.x * rs, v.y * rs); o[1] = pack2(v.z * rs, v.w * rs);
            *(u32x2*)(p.Rg + (size_t)(m0 + row) * 1024 + (n0 - 2048) + c4) = o;
          } else if (c4 < 16) {
            float4 o = make_float4(v.x * rs, v.y * rs, v.z * rs, v.w * rs);
            *(float4*)(p.GA + (size_t)(m0 + row) * 16 + c4) = o;
          }
        }
      }
    } else if (g.epi == EPI_RESID) {
      float4 xr[16];
#pragma unroll
      for (int it = 0; it < 16; ++it) {
        const int idx = tid + 256 * (it < ritn ? it : 0), row = idx >> 5, c4 = (idx & 31) * 4;
        const int grow = m0 + row;
        const float* xi = grow < RP ? g.xin_p + (size_t)grow * DM : g.xin_s + (size_t)(grow - RP) * DM;
        xr[it] = *(const float4*)(xi + n0 + c4);
      }
#pragma unroll
      for (int it = 0; it < 16; ++it) if (it < ritn) {
        const int idx = tid + 256 * it, row = idx >> 5, c4 = (idx & 31) * 4;
        float4 v = *(const float4*)&Cs[row * 132 + c4];
        const int grow = m0 + row;
        const float4 x = xr[it];
        v.x += x.x; v.y += x.y; v.z += x.z; v.w += x.w;
        *(float4*)(g.xout + (size_t)grow * DM + n0 + c4) = v;
        if (g.write_xb) {
          u32x2 o; o[0] = pack2(v.x, v.y); o[1] = pack2(v.z, v.w);
          *(u32x2*)(p.xb + (size_t)grow * DM + n0 + c4) = o;
          float ss = v.x * v.x + v.y * v.y + v.z * v.z + v.w * v.w;
          for (int m = 1; m < 32; m <<= 1) ss += __shfl_xor(ss, m);
          if ((lane & 31) == 0) p.rsp[(size_t)nt * R + grow] = ss;
        }
      }
    } else if (g.epi == EPI_FFN_IN) {
      const int l = g.layer;
      const bool halo = (m0 < RP) && ((m0 & 8191) != 0);
      if (tid < 130) { const int rr = m0 - 2 + tid; rsS[tid] = rr >= 0 ? rowscale(p.rsp, 8, rr) : 0.f; }
      const int par = mt & 1;
      if (halo && !carried) {
        *(u32x4*)((char*)xh + tid * 16) = *(const u32x4*)(p.xb + (size_t)(m0 - 2) * DM + tid * 8);
        __syncthreads();
        const int c = tid & 63, hr = (tid >> 6) & 1, kh = tid >> 7;
        const u16* wb = g.B + (size_t)(n0 + c) * DM + kh * 512;
        const char* xa = (const char*)xh + hr * 2048 + kh * 1024;
        float sacc = 0.f;
#pragma unroll 1
        for (int k = 0; k < 512; k += 128) {
          u32x4 wv[16];
#pragma unroll
          for (int q = 0; q < 16; ++q) wv[q] = *(const u32x4*)(wb + k + q * 8);
#pragma unroll
          for (int q = 0; q < 16; ++q) {
            const u32x4 a = *(const u32x4*)(xa + (k + q * 8) * 2);
#pragma unroll
            for (int e = 0; e < 4; ++e) sacc += bflo(a[e]) * bflo(wv[q][e]) + bfhi(a[e]) * bfhi(wv[q][e]);
          }
        }
        Hp[(kh * 2 + hr) * 64 + c] = sacc;
      }
      __syncthreads();
      if (tid < 128) {
        const int c = tid & 63, hr = tid >> 6;
        float hv = 0.f;
        if (halo) hv = carried ? Hc[(par ^ 1) * 128 + hr * 64 + c] : (Hp[hr * 64 + c] + Hp[(2 + hr) * 64 + c]) * rsS[hr];
        Hs[hr * 64 + c] = hv;
        Hc[par * 128 + hr * 64 + c] = Cs[(126 + hr) * 132 + c] * rsS[128 + hr];
      }
      __syncthreads();
      const float* cw = p.in[9] + (size_t)l * 3 * DFF;
      const float* cb = p.in[10] + (size_t)l * DFF;
      const int colh = nt * 64 + (tid & 15) * 4;
      const float4 w0 = *(const float4*)(cw + colh), w1 = *(const float4*)(cw + DFF + colh), w2 = *(const float4*)(cw + 2 * DFF + colh), bb = *(const float4*)(cb + colh);
      for (int it = 0; it < 8; ++it) {
        const int idx = tid + 256 * it, row = idx >> 4, c4 = (idx & 15) * 4;
        const int grow = m0 + row, col = nt * 64 + c4;
        const float rs0 = rsS[row + 2];
        float4 g0 = *(const float4*)&Cs[row * 132 + c4];
        float4 u = *(const float4*)&Cs[row * 132 + 64 + c4];
        g0.x *= rs0; g0.y *= rs0; g0.z *= rs0; g0.w *= rs0;
        float4 g1, g2;
        int t; const float* st = nullptr;
        if (grow < RP) { t = grow & 8191; } else { t = (grow - RP) & 31; st = p.in[3] + ((size_t)(l * 16 + ((grow - RP) >> 5)) * 2) * DFF + col; }
        if (t >= 1) {
          if (row >= 1) { const float rs1 = rsS[row + 1]; g1 = *(const float4*)&Cs[(row - 1) * 132 + c4]; g1.x *= rs1; g1.y *= rs1; g1.z *= rs1; g1.w *= rs1; }
          else g1 = *(const float4*)&Hs[64 + c4];
        } else { g1 = st ? *(const float4*)(st + DFF) : make_float4(0.f, 0.f, 0.f, 0.f); }
        if (t >= 2) {
          if (row >= 2) { const float rs2 = rsS[row]; g2 = *(const float4*)&Cs[(row - 2) * 132 + c4]; g2.x *= rs2; g2.y *= rs2; g2.z *= rs2; g2.w *= rs2; }
          else g2 = *(const float4*)&Hs[row * 64 + c4];
        } else { g2 = st ? *(const float4*)(st + (size_t)t * DFF) : make_float4(0.f, 0.f, 0.f, 0.f); }
        float a0 = gelu_exact(bb.x + w0.x * g2.x + w1.x * g1.x + w2.x * g0.x) * (u.x * rs0);
        float a1 = gelu_exact(bb.y + w0.y * g2.y + w1.y * g1.y + w2.y * g0.y) * (u.y * rs0);
        float a2 = gelu_exact(bb.z + w0.z * g2.z + w1.z * g1.z + w2.z * g0.z) * (u.z * rs0);
        float a3 = gelu_exact(bb.w + w0.w * g2.w + w1.w * g1.w + w2.w * g0.w) * (u.w * rs0);
        u32x2 o; o[0] = pack2(a0, a1); o[1] = pack2(a2, a3);
        *(u32x2*)(p.act + (size_t)grow * DFF + col) = o;
        if (grow < RP) {
          if (t >= 8190) *(float4*)(p.out + O_FFNP + ((size_t)(l * 2 + (grow >> 13)) * 2 + (t - 8190)) * DFF + col) = g0;
        } else if (t >= 30) {
          *(float4*)(p.out + O_FFNS + ((size_t)(l * 16 + ((grow - RP) >> 5)) * 2 + (t - 30)) * DFF + col) = g0;
        }
      }
    } else if (g.epi == EPI_DKVQ) {
      if (tid < 128) rsS[tid] = rowscale(p.rsp, 8, m0 + tid);
      __syncthreads();
      for (int it = 0; it < 16; ++it) {
        const int idx = tid + 256 * it, row = idx >> 5, c4 = (idx & 31) * 4;
        float4 v = *(const float4*)&Cs[row * 132 + c4];
        const float rs = rsS[row];
        v.x *= rs; v.y *= rs; v.z *= rs; v.w *= rs;
        *(float4*)(p.RAW + (size_t)(m0 + row) * 896 + n0 + c4) = v;
      }
    } else if (g.epi == EPI_UKV) {
      const int hd = nt >> 1;
      const int b = m0 >> 13, t0 = m0 & 8191;
      for (int it = 0; it < 16; ++it) {
        const int idx = tid + 256 * it, row = idx >> 5, c4 = (idx & 31) * 4;
        float4 v = *(const float4*)&Cs[row * 132 + c4];
        if (swap) {
          u32x2 o; o[0] = pack2(v.x, v.y); o[1] = pack2(v.z, v.w);
          *(u32x2*)(p.Vtp + ((size_t)((b * 8 + hd) * 128 + row)) * 8192 + t0 + c4) = o;
        } else {
          float ss = v.x * v.x + v.y * v.y + v.z * v.z + v.w * v.w;
          for (int m = 1; m < 32; m <<= 1) ss += __shfl_xor(ss, m);
          const float rs = rsqrtf(ss * (1.0f / 128.0f) + EPS);
          u32x2 o; o[0] = pack2(v.x * rs, v.y * rs); o[1] = pack2(v.z * rs, v.w * rs);
          *(u32x2*)(p.Knp + ((size_t)((b * 8 + hd) * 8192 + t0 + row)) * 128 + c4) = o;
        }
      }
    } else if (g.epi == EPI_UQ) {
      const float QS = 0.07216878364870322f * 1.4426950408889634f;
      const int c4h = (tid & 31) * 4;
      const float4 hg1 = *(const float4*)(p.in[21] + c4h), hg2 = *(const float4*)(p.in[28] + c4h), hgq = *(const float4*)(p.in[22] + (c4h & 63));
      for (int it = 0; it < 16; ++it) {
        const int idx = tid + 256 * it, row = idx >> 5, c4 = (idx & 31) * 4;
        float4 v = *(const float4*)&Cs[row * 132 + c4];
        const int grow = m0 + row;
        float ss = v.x * v.x + v.y * v.y + v.z * v.z + v.w * v.w;
        if (nt < 8) {
          for (int m = 1; m < 32; m <<= 1) ss += __shfl_xor(ss, m);
          const float rs = rsqrtf(ss * (1.0f / 128.0f) + EPS) * QS;
          const float4 g1 = hg1, g2 = hg2;
          u32x2 o; o[0] = pack2(v.x * rs * g1.x * g2.x, v.y * rs * g1.y * g2.y); o[1] = pack2(v.z * rs * g1.z * g2.z, v.w * rs * g1.w * g2.w);
          *(u32x2*)(p.Qb + (size_t)grow * 1536 + nt * 192 + c4) = o;
        } else {
          for (int m = 1; m < 16; m <<= 1) ss += __shfl_xor(ss, m);
          const float rs = rsqrtf(ss * (1.0f / 64.0f) + EPS);
          const int dd = c4 & 63, hd = (nt - 8) * 2 + (c4 >> 6);
          const float4 gq = hgq;
          float own[4] = {v.x * rs * gq.x, v.y * rs * gq.y, v.z * rs * gq.z, v.w * rs * gq.w};
          float res[4];
          const float pos = (float)row_pos(grow);
#pragma unroll
          for (int q = 0; q < 4; ++q) {
            const float other = __shfl_xor(own[q], 8);
            const int di = (dd + q) & 31;
            const float inv = exp2f(-(float)di * (2.0f / 64.0f) * 13.287712379549449f);
            float sn, cs; sincosf(pos * inv, &sn, &cs);
            res[q] = (dd < 32) ? own[q] * cs - other * sn : other * sn + own[q] * cs;
          }
          u32x2 o; o[0] = pack2(res[0] * QS, res[1] * QS); o[1] = pack2(res[2] * QS, res[3] * QS);
          *(u32x2*)(p.Qb + (size_t)grow * 1536 + hd * 192 + 128 + dd) = o;
        }
      }
    }
    __syncthreads();
   }
  }
}

DI void slot_decode(int slot, int& row0, int& h, int& L) {
  if (slot < 1024) { const int ch = slot >> 7, c = slot & 127; row0 = (ch >> 2) * 8192 + c * 64; h = ch & 3; L = 64; }
  else { const int sbh = slot - 1024; row0 = RP + (sbh >> 2) * 32; h = sbh & 3; L = 32; }
}

DI void phase_gla_a(const Params& p, char* smem) {
  float* gaS = (float*)smem;
  float* bcS = (float*)(smem + 4096);
  float* tot = (float*)(smem + 36864);
  u16* keT = (u16*)(smem + 37888);
  const float* w_a2 = p.in[14]; const float* b_a = p.in[15];
  for (int slot = blockIdx.x; slot < NSLOT; slot += gridDim.x) {
    int row0, h, L; slot_decode(slot, row0, h, L);
    int tid = threadIdx.x; asm volatile("" : "+v"(tid));
    const int lane = tid & 63, w = tid >> 6, r = lane & 31, hh = lane >> 5;
    {
      const int t = tid >> 2, j4 = (tid & 3) * 4;
      float4 v = make_float4(0.f, 0.f, 0.f, 0.f);
      if (t < L) v = *(const float4*)(p.GA + (size_t)(row0 + t) * 16 + j4);
      *(float4*)&gaS[t * 16 + j4] = v;
    }
    __syncthreads();
    const int d = tid & 127, half = tid >> 7;
    {
      float w2[16];
#pragma unroll
      for (int j = 0; j < 16; ++j) w2[j] = w_a2[j * 512 + h * 128 + d];
      const float ba = b_a[h * 128 + d];
      float cum = 0.f;
      for (int tt = 0; tt < 32; ++tt) {
        const int t = half * 32 + tt;
        float z = ba;
#pragma unroll
        for (int j = 0; j < 16; ++j) z += gaS[t * 16 + j] * w2[j];
        float la = (fminf(z, 0.f) - log1pf(expf(-fabsf(z)))) * (1.0f / 16.0f);
        if (t >= L) la = 0.f;
        cum += la;
        bcS[t * 128 + d] = cum;
      }
      tot[half * 128 + d] = cum;
    }
    __syncthreads();
    {
      const float blast = tot[d] + tot[128 + d];
      const float off = half ? tot[d] : 0.f;
      u16* qbase = p.Qg + (size_t)row0 * 512 + h * 128;
      u16* kbase = p.Kg + (size_t)row0 * 512 + h * 128;
#pragma unroll 1
      for (int t8 = 0; t8 < 32; t8 += 8) {
        u16 qv[8], kv[8];
#pragma unroll
        for (int q8 = 0; q8 < 8; ++q8) {
          const int t = half * 32 + t8 + q8;
          const unsigned gi = (unsigned)((t < L ? t : 0) * 512 + d);
          qv[q8] = qbase[gi]; kv[q8] = kbase[gi];
        }
#pragma unroll
        for (int q8 = 0; q8 < 8; ++q8) {
          const int t = half * 32 + t8 + q8;
          u16 kev = 0;
          if (t < L) {
            const float b = bcS[t * 128 + d] + off;
            const unsigned gi = (unsigned)(t * 512 + d);
            qbase[gi] = f2bf(bf2f(qv[q8]) * expf(b - blast));
            kev = f2bf(bf2f(kv[q8]) * expf(blast - b));
            kbase[gi] = kev;
          }
          keT[d * 72 + t] = kev;
        }
      }
      if (half == 0) p.dec[(size_t)slot * 128 + d] = expf(blast);
    }
    __syncthreads();
    const int nks = L >> 4;
    for (int rt = 0; rt < 2; ++rt) {
      f32x16 acc[4];
      for (int ct = 0; ct < 4; ++ct) acc[ct] = zero16();
      const u16* vrow = p.Vt + (size_t)(h * 256 + w * 64 + rt * 32 + r) * R + row0 + hh * 8;
      bf16x8 av[4];
#pragma unroll
      for (int s = 0; s < 4; ++s) av[s] = *(const bf16x8*)(vrow + (s < nks ? s : 0) * 16);
#pragma unroll
      for (int s = 0; s < 4; ++s) {
        if (s >= nks) break;
        const bf16x8 a = av[s];
#pragma unroll
        for (int ct = 0; ct < 4; ++ct) {
          const bf16x8 b = *(const bf16x8*)(keT + (ct * 32 + r) * 72 + s * 16 + hh * 8);
          acc[ct] = MFMA(a, b, acc[ct]);
        }
      }
      u16* ub = p.US + (size_t)slot * 32768;
#pragma unroll
      for (int ct = 0; ct < 4; ++ct)
#pragma unroll
        for (int i = 0; i < 16; ++i)
          ub[(w * 64 + rt * 32 + crow(i, hh)) * 128 + ct * 32 + r] = f2bf(acc[ct][i]);
    }
    __syncthreads();
  }
}

DI void phase_gla_scan(const Params& p) {
  const int total = 72 * 16384;
  for (int it = blockIdx.x * 256 + threadIdx.x; it < total; it += gridDim.x * 256) {
    const int ch = it >> 14, e = it & 16383, dv = e >> 6, dk = (e & 63) * 2;
    int nchunk, slot0; float S0 = 0.f, S1 = 0.f; float* outp;
    if (ch < 8) { nchunk = 128; slot0 = ch * 128; outp = p.out + O_GLAP + (size_t)ch * 32768; }
    else {
      const int sbh = ch - 8; nchunk = 1; slot0 = 1024 + sbh; outp = p.out + O_GLAS + (size_t)sbh * 32768;
      S0 = p.in[2][((size_t)sbh * 128 + dk) * 256 + dv]; S1 = p.in[2][((size_t)sbh * 128 + dk + 1) * 256 + dv];
    }
    unsigned* ub = (unsigned*)(p.US + (size_t)slot0 * 32768 + dv * 128 + dk);
    const float* db = p.dec + (size_t)slot0 * 128 + dk;
    if (nchunk == 1) {
      const unsigned u = ub[0]; const float2 dd = *(const float2*)db;
      const float s0 = dd.x * S0, s1 = dd.y * S1;
      ub[0] = pack2(s0, s1);
      S0 = s0 + bflo(u); S1 = s1 + bfhi(u);
    } else {
      for (int c0 = 0; c0 < nchunk; c0 += 8) {
        unsigned u[8]; float2 dd[8];
#pragma unroll
        for (int q = 0; q < 8; ++q) { u[q] = ub[(size_t)(c0 + q) * 16384]; dd[q] = *(const float2*)(db + (size_t)(c0 + q) * 128); }
#pragma unroll
        for (int q = 0; q < 8; ++q) {
          const float s0 = dd[q].x * S0, s1 = dd[q].y * S1;
          ub[(size_t)(c0 + q) * 16384] = pack2(s0, s1);
          S0 = s0 + bflo(u[q]); S1 = s1 + bfhi(u[q]);
        }
      }
    }
    outp[(size_t)dk * 256 + dv] = S0; outp[(size_t)(dk + 1) * 256 + dv] = S1;
  }
}

DI void phase_gla_c(const Params& p, char* smem) {
  const int tid = threadIdx.x, lane = tid & 63, w = tid >> 6, r = lane & 31, hh = lane >> 5;
  float* red = (float*)smem;
  const float* gnorm = p.in[16];
  for (int slot = blockIdx.x; slot < NSLOT; slot += gridDim.x) {
    int row0, h, L; slot_decode(slot, row0, h, L);
    const int nit = L >> 5;
    bf16x8 qf[2][8];
#pragma unroll
    for (int it = 0; it < 2; ++it)
#pragma unroll
      for (int s = 0; s < 8; ++s) {
        if (it < nit) qf[it][s] = *(const bf16x8*)(p.Qg + (size_t)(row0 + it * 32 + r) * 512 + h * 128 + s * 16 + hh * 8);
        else { bf16x8 z; for (int q = 0; q < 8; ++q) z[q] = 0; qf[it][s] = z; }
      }
    f32x16 X00 = zero16(), X01 = zero16(), X11 = zero16();
#pragma unroll
    for (int s = 0; s < 8; ++s) {
      const bf16x8 k0 = *(const bf16x8*)(p.Kg + (size_t)(row0 + r) * 512 + h * 128 + s * 16 + hh * 8);
      X00 = MFMA(k0, qf[0][s], X00);
      if (nit == 2) {
        const bf16x8 k1 = *(const bf16x8*)(p.Kg + (size_t)(row0 + 32 + r) * 512 + h * 128 + s * 16 + hh * 8);
        X01 = MFMA(k0, qf[1][s], X01);
        X11 = MFMA(k1, qf[1][s], X11);
      }
    }
#pragma unroll
    for (int i = 0; i < 16; ++i) { if (crow(i, hh) > r) { X00[i] = 0.f; X11[i] = 0.f; } }
    f32x16 acc[2][2];
    for (int a = 0; a < 2; ++a) for (int b = 0; b < 2; ++b) acc[a][b] = zero16();
#pragma unroll
    for (int s2 = 0; s2 < 2; ++s2) {
      const bf16x8 p00 = pack8(X00, s2), p01 = pack8(X01, s2), p11 = pack8(X11, s2);
#pragma unroll
      for (int rt = 0; rt < 2; ++rt) {
        const u16* vrow = p.Vt + (size_t)(h * 256 + w * 64 + rt * 32 + r) * R + row0 + s2 * 16 + 4 * hh;
        {
          const s16x4 lo = *(const s16x4*)(vrow), hi = *(const s16x4*)(vrow + 8);
          const bf16x8 va = __builtin_shufflevector(lo, hi, 0, 1, 2, 3, 4, 5, 6, 7);
          acc[rt][0] = MFMA(va, p00, acc[rt][0]);
          if (nit == 2) acc[rt][1] = MFMA(va, p01, acc[rt][1]);
        }
        if (nit == 2) {
          const s16x4 lo = *(const s16x4*)(vrow + 32), hi = *(const s16x4*)(vrow + 40);
          const bf16x8 va = __builtin_shufflevector(lo, hi, 0, 1, 2, 3, 4, 5, 6, 7);
          acc[rt][1] = MFMA(va, p11, acc[rt][1]);
        }
      }
    }
#pragma unroll
    for (int s = 0; s < 8; ++s)
#pragma unroll
      for (int rt = 0; rt < 2; ++rt) {
        const bf16x8 sa = *(const bf16x8*)(p.US + (size_t)slot * 32768 + (w * 64 + rt * 32 + r) * 128 + s * 16 + hh * 8);
        acc[rt][0] = MFMA(sa, qf[0][s], acc[rt][0]);
        if (nit == 2) acc[rt][1] = MFMA(sa, qf[1][s], acc[rt][1]);
      }
#pragma unroll
    for (int it = 0; it < 2; ++it) {
      float ss = 0.f;
#pragma unroll
      for (int rt = 0; rt < 2; ++rt)
#pragma unroll
        for (int i = 0; i < 16; ++i) ss += acc[rt][it][i] * acc[rt][it][i];
      ss += __shfl_xor(ss, 32);
      if (hh == 0) red[w * 64 + it * 32 + r] = ss;
    }
    __syncthreads();
    {
      u32x2 rgv[2][2][4];
#pragma unroll
      for (int it = 0; it < 2; ++it)
#pragma unroll
        for (int rt = 0; rt < 2; ++rt)
#pragma unroll
          for (int gq = 0; gq < 4; ++gq) {
            const int ti = (it < nit ? it : 0) * 32 + r;
            rgv[it][rt][gq] = *(const u32x2*)(p.Rg + (size_t)(row0 + ti) * 1024 + h * 256 + w * 64 + rt * 32 + 8 * gq + 4 * hh);
          }
#pragma unroll
      for (int it = 0; it < 2; ++it) {
        if (it < nit) {
          const int ti = it * 32 + r;
          const float tot = red[ti] + red[64 + ti] + red[128 + ti] + red[192 + ti];
          const float rs = rsqrtf(tot * (1.0f / 256.0f) + EPS);
#pragma unroll
          for (int rt = 0; rt < 2; ++rt)
#pragma unroll
            for (int gq = 0; gq < 4; ++gq) {
              const int dv = w * 64 + rt * 32 + 8 * gq + 4 * hh;
              u16* rp = p.Rg + (size_t)(row0 + ti) * 1024 + h * 256 + dv;
              const u32x2 rg = rgv[it][rt][gq];
              const float4 gn = *(const float4*)(gnorm + dv);
              const float r0 = bflo(rg[0]), r1 = bfhi(rg[0]), r2 = bflo(rg[1]), r3 = bfhi(rg[1]);
              const float o0 = acc[rt][it][4 * gq + 0] * rs * gn.x * (r0 / (1.0f + expf(-r0)));
              const float o1 = acc[rt][it][4 * gq + 1] * rs * gn.y * (r1 / (1.0f + expf(-r1)));
              const float o2 = acc[rt][it][4 * gq + 2] * rs * gn.z * (r2 / (1.0f + expf(-r2)));
              const float o3 = acc[rt][it][4 * gq + 3] * rs * gn.w * (r3 / (1.0f + expf(-r3)));
              u32x2 o; o[0] = pack2(o0, o1); o[1] = pack2(o2, o3);
              *(u32x2*)rp = o;
            }
        }
      }
    }
    __syncthreads();
  }
}

DI void phase_e2(const Params& p) {
  const int tid = threadIdx.x, lane = tid & 63, w = tid >> 6;
  const int nRow = R / 4, nC = 8192, nK = 2048;
  for (int j = blockIdx.x; j < nRow + nC + nK; j += gridDim.x) {
    if (j < nRow) {
      const int row = j * 4 + w;
      const float* raw = p.RAW + (size_t)row * 896;
      const int pos = row_pos(row);
      const float4 pre_ckv = *(const float4*)(raw + lane * 4);
      const float pre_kpe = raw[256 + lane];
      const float4 pre_q0 = *(const float4*)(raw + 384 + lane * 8), pre_q1 = *(const float4*)(raw + 384 + lane * 8 + 4);
      {
        const float4 v = pre_ckv;
        float ss = v.x * v.x + v.y * v.y + v.z * v.z + v.w * v.w;
        for (int m = 1; m < 64; m <<= 1) ss += __shfl_xor(ss, m);
        const float rs = rsqrtf(ss * (1.0f / 256.0f) + EPS);
        const float4 g = *(const float4*)(p.in[26] + lane * 4);
        const float4 o = make_float4(v.x * rs * g.x, v.y * rs * g.y, v.z * rs * g.z, v.w * rs * g.w);
        u32x2 ob; ob[0] = pack2(o.x, o.y); ob[1] = pack2(o.z, o.w);
        if (row < RP) {
          *(float4*)(p.out + O_CKVP + (size_t)row * 256 + lane * 4) = o;
          *(u32x2*)(p.ACKVp + (size_t)row * 256 + lane * 4) = ob;
        } else {
          const int rr = row - RP, sb = rr >> 5, t = rr & 31;
          *(float4*)(p.out + O_CKVS + (size_t)rr * 256 + lane * 4) = o;
          *(u32x2*)(p.ACKVs + ((size_t)sb * TS + 4096 + t) * 256 + lane * 4) = ob;
        }
      }
      {
        const float v = pre_kpe;
        float ss = v * v;
        for (int m = 1; m < 64; m <<= 1) ss += __shfl_xor(ss, m);
        const float rs = rsqrtf(ss * (1.0f / 64.0f) + EPS);
        const float own = v * rs * p.in[29][lane];
        const float other = __shfl_xor(own, 32);
        const int di = lane & 31;
        const float inv = exp2f(-(float)di * (2.0f / 64.0f) * 13.287712379549449f);
        float sn, cs; sincosf((float)pos * inv, &sn, &cs);
        const float o = lane < 32 ? own * cs - other * sn : other * sn + own * cs;
        if (row < RP) {
          p.out[O_KPEP + (size_t)row * 64 + lane] = o;
          p.AKPEp[(size_t)row * 64 + lane] = f2bf(o);
        } else {
          const int rr = row - RP, sb = rr >> 5, t = rr & 31;
          p.out[O_KPES + (size_t)rr * 64 + lane] = o;
          p.AKPEs[((size_t)sb * TS + 4096 + t) * 64 + lane] = f2bf(o);
        }
      }
      {
        const float4 v0 = pre_q0, v1 = pre_q1;
        float ss = v0.x * v0.x + v0.y * v0.y + v0.z * v0.z + v0.w * v0.w + v1.x * v1.x + v1.y * v1.y + v1.z * v1.z + v1.w * v1.w;
        for (int m = 1; m < 64; m <<= 1) ss += __shfl_xor(ss, m);
        const float rs = rsqrtf(ss * (1.0f / 512.0f) + EPS);
        const float4 g0 = *(const float4*)(p.in[19] + lane * 8), g1 = *(const float4*)(p.in[19] + lane * 8 + 4);
        u32x4 o;
        o[0] = pack2(v0.x * rs * g0.x, v0.y * rs * g0.y); o[1] = pack2(v0.z * rs * g0.z, v0.w * rs * g0.w);
        o[2] = pack2(v1.x * rs * g1.x, v1.y * rs * g1.y); o[3] = pack2(v1.z * rs * g1.z, v1.w * rs * g1.w);
        *(u32x4*)(p.CQN + (size_t)row * 512 + lane * 8) = o;
      }
    } else if (j < nRow + nC) {
      const size_t e = (size_t)(j - nRow) * 2048 + tid * 8;
      const int sb = (int)(e >> 20); const size_t rem = e & 1048575;
      const float4 a = *(const float4*)(p.in[4] + e), b = *(const float4*)(p.in[4] + e + 4);
      u32x4 o; o[0] = pack2(a.x, a.y); o[1] = pack2(a.z, a.w); o[2] = pack2(b.x, b.y); o[3] = pack2(b.z, b.w);
      *(u32x4*)(p.ACKVs + (size_t)sb * TS * 256 + rem) = o;
    } else {
      const size_t e = (size_t)(j - nRow - nC) * 2048 + tid * 8;
      const int sb = (int)(e >> 18); const size_t rem = e & 262143;
      const float4 a = *(const float4*)(p.in[5] + e), b = *(const float4*)(p.in[5] + e + 4);
      u32x4 o; o[0] = pack2(a.x, a.y); o[1] = pack2(a.z, a.w); o[2] = pack2(b.x, b.y); o[3] = pack2(b.z, b.w);
      *(u32x4*)(p.AKPEs + (size_t)sb * TS * 64 + rem) = o;
    }
  }
}

DI void attn_step(const char* Ks, const char* Vts, const bf16x8 (&qf)[12], f32x16 (&o)[4], float& m, float& l, int r, int hh, int nvalid) {
  f32x16 sv[2]; sv[0] = zero16(); sv[1] = zero16();
#pragma unroll
  for (int k2 = 0; k2 < 2; ++k2)
#pragma unroll
    for (int ks = 0; ks < 12; ++ks) {
      const bf16x8 a = *(const bf16x8*)(Ks + (k2 * 32 + r) * 400 + (ks * 16 + hh * 8) * 2);
      sv[k2] = MFMA(a, qf[ks], sv[k2]);
    }
#pragma unroll
  for (int k2 = 0; k2 < 2; ++k2) {
    float mx = sv[k2][0];
#pragma unroll
    for (int i = 1; i < 16; ++i) mx = fmaxf(mx, sv[k2][i]);
    mx = fmaxf(mx, __shfl_xor(mx, 32));
    const float mn = fmaxf(m, mx);
    const float alpha = __builtin_amdgcn_exp2f(m - mn);
    float ps = 0.f;
#pragma unroll
    for (int i = 0; i < 16; ++i) { const float pv = __builtin_amdgcn_exp2f(sv[k2][i] - mn); ps += pv; sv[k2][i] = pv; }
    l = l * alpha + ps; m = mn;
    if (__any(alpha != 1.0f)) {
#pragma unroll
      for (int dt = 0; dt < 4; ++dt)
#pragma unroll
        for (int i = 0; i < 16; ++i) o[dt][i] *= alpha;
    }
#pragma unroll
    for (int s2 = 0; s2 < 2; ++s2) {
      const bf16x8 pb = pack8(sv[k2], s2);
#pragma unroll
      for (int dt = 0; dt < 4; ++dt) {
        const char* vp = Vts + (dt * 32 + r) * 136 + (k2 * 32 + s2 * 16 + hh * 4) * 2;
        const s16x4 lo = *(const s16x4*)vp, hi = *(const s16x4*)(vp + 16);
        const bf16x8 va = __builtin_shufflevector(lo, hi, 0, 1, 2, 3, 4, 5, 6, 7);
        o[dt] = MFMA(va, pb, o[dt]);
      }
    }
  }
}

DI void attn_step_part(const char* Ks, const char* Vts, const char* Qp, const bf16x8 (&qf)[4], f32x16 (&o)[2], float& m, float& l, int r, int hh, int k2, int dvh) {
  f32x16 s = zero16();
#pragma unroll
  for (int ks = 0; ks < 12; ++ks) {
    bf16x8 qb;
    if (ks < 4) qb = qf[ks < 4 ? ks : 0]; else qb = *(const bf16x8*)(Qp + ((ks - 4) * 16 + hh * 8) * 2);
    const bf16x8 a = *(const bf16x8*)(Ks + (k2 * 32 + r) * 400 + (ks * 16 + hh * 8) * 2);
    s = MFMA(a, qb, s);
  }
  float mx = s[0];
#pragma unroll
  for (int i = 1; i < 16; ++i) mx = fmaxf(mx, s[i]);
  mx = fmaxf(mx, __shfl_xor(mx, 32));
  const float mn = fmaxf(m, mx);
  const float alpha = __builtin_amdgcn_exp2f(m - mn);
  float ps = 0.f;
#pragma unroll
  for (int i = 0; i < 16; ++i) { const float pv = __builtin_amdgcn_exp2f(s[i] - mn); ps += pv; s[i] = pv; }
  l = l * alpha + ps; m = mn;
#pragma unroll
  for (int d2 = 0; d2 < 2; ++d2)
#pragma unroll
    for (int i = 0; i < 16; ++i) o[d2][i] *= alpha;
#pragma unroll
  for (int s2 = 0; s2 < 2; ++s2) {
    const bf16x8 pb = pack8(s, s2);
#pragma unroll
    for (int d2 = 0; d2 < 2; ++d2) {
      const char* vp = Vts + ((dvh * 2 + d2) * 32 + r) * 136 + (k2 * 32 + s2 * 16 + hh * 4) * 2;
      const s16x4 lo = *(const s16x4*)vp, hi = *(const s16x4*)(vp + 16);
      const bf16x8 va = __builtin_shufflevector(lo, hi, 0, 1, 2, 3, 4, 5, 6, 7);
      o[d2] = MFMA(va, pb, o[d2]);
    }
  }
}

DI void attn_store(const Params& p, const f32x16 (&o)[4], float l, int grow, int h, int hh) {
  const float lt = l + __shfl_xor(l, 32);
  const float inv = 1.0f / lt;
#pragma unroll
  for (int dt = 0; dt < 4; ++dt)
#pragma unroll
    for (int gq = 0; gq < 4; ++gq) {
      u32x2 ov; ov[0] = pack2(o[dt][4 * gq] * inv, o[dt][4 * gq + 1] * inv); ov[1] = pack2(o[dt][4 * gq + 2] * inv, o[dt][4 * gq + 3] * inv);
      *(u32x2*)(p.ao + (size_t)grow * 1024 + h * 128 + dt * 32 + 8 * gq + 4 * hh) = ov;
    }
}

DI void attn_prompt_item(const Params& p, char* smem, int b, int h, int mq, int desc) {
  int tid = threadIdx.x; asm volatile("" : "+v"(tid));
  const int lane = tid & 63, w = tid >> 6, r = lane & 31, hh = lane >> 5;
  char* Ks = smem; char* Vts = smem + 25600;
  const int grow = b * 8192 + mq * 128 + w * 32 + r;
  bf16x8 qf[12];
#pragma unroll
  for (int s = 0; s < 12; ++s) qf[s] = *(const bf16x8*)(p.Qb + (size_t)grow * 1536 + h * 192 + s * 16 + hh * 8);
  f32x16 o[4]; for (int dt = 0; dt < 4; ++dt) o[dt] = zero16();
  float m = -INFINITY, l = 0.f;
  const int ntiles = 2 * mq + 2, mytiles = 2 * mq + 1 + (w >> 1);
  const u16* kn = p.Knp + (size_t)(b * 8 + h) * 8192 * 128;
  const u16* kp = p.AKPEp + (size_t)b * 8192 * 64;
  const u16* vt = p.Vtp + (size_t)(b * 8 + h) * 128 * 8192;
  u32x4 rk[4], rp[2], rv[4];
  const unsigned okn = (unsigned)((tid >> 4) * 128 + (tid & 15) * 8);
  const unsigned okp = (unsigned)((tid >> 3) * 64 + (tid & 7) * 8);
  const unsigned ovt = (unsigned)((tid >> 3) * 8192 + (tid & 7) * 8);
  auto gload = [&](int kt) {
    const u16* knt = kn + (size_t)kt * 64 * 128;
    const u16* kpt = kp + (size_t)kt * 64 * 64;
    const u16* vtt = vt + (size_t)kt * 64;
#pragma unroll
    for (int i = 0; i < 4; ++i) rk[i] = *(const u32x4*)(knt + i * 2048 + okn);
#pragma unroll
    for (int i = 0; i < 2; ++i) rp[i] = *(const u32x4*)(kpt + i * 2048 + okp);
#pragma unroll
    for (int i = 0; i < 4; ++i) rv[i] = *(const u32x4*)(vtt + (size_t)i * 32 * 8192 + ovt);
  };
  gload(desc ? ntiles - 1 : 0);
  for (int ki = 0; ki < ntiles; ++ki) {
    const int kt = desc ? ntiles - 1 - ki : ki;
    __syncthreads();
#pragma unroll
    for (int i = 0; i < 4; ++i) { const int c = tid + 256 * i; *(u32x4*)(Ks + (c >> 4) * 400 + (c & 15) * 16) = rk[i]; }
#pragma unroll
    for (int i = 0; i < 2; ++i) { const int c = tid + 256 * i; *(u32x4*)(Ks + (c >> 3) * 400 + 256 + (c & 7) * 16) = rp[i]; }
#pragma unroll
    for (int i = 0; i < 4; ++i) {
      const int c = tid + 256 * i; char* d = Vts + (c >> 3) * 136 + (c & 7) * 16;
      u32x2 a, bq; a[0] = rv[i][0]; a[1] = rv[i][1]; bq[0] = rv[i][2]; bq[1] = rv[i][3];
      *(u32x2*)d = a; *(u32x2*)(d + 8) = bq;
    }
    __syncthreads();
    if (ki + 1 < ntiles) gload(desc ? kt - 1 : kt + 1);
    if (kt < mytiles) attn_step(Ks, Vts, qf, o, m, l, r, hh, 64);
  }
  attn_store(p, o, l, grow, h, hh);
}

DI void attn_sample_item(const Params& p, char* smem, int item, int sb, int h) {
  int tid = threadIdx.x; asm volatile("" : "+v"(tid));
  const int lane = tid & 63, w = tid >> 6, r = lane & 31, hh = lane >> 5;
  char* Ks = smem; char* Vts = smem + 25600;
  const int grow = RP + sb * 32 + r;
  f32x16 o[2]; o[0] = zero16(); o[1] = zero16();
  float m = -INFINITY, l = 0.f;
  const u16* ck = p.ACKVs + (size_t)sb * TS * 256;
  const u16* kpe = p.AKPEs + (size_t)sb * TS * 64;
  const u16* wk = p.Wukv + (size_t)(h * 256) * 256;
  const u16* wv = p.Wukv + (size_t)(h * 256 + 128) * 256;
  u16* sK = p.CQN + (size_t)item * 81920;
  u16* sV = sK + 32768;
  float* sO = (float*)(sK + 65536);
#pragma unroll 1
  for (int c = 0; c < 17; ++c) {
    const int kbase = c * 256;
    int tid = threadIdx.x; asm volatile("" : "+v"(tid));
    const int lane = tid & 63, w = tid >> 6, r = lane & 31, hh = lane >> 5;
    const int grow = RP + sb * 32 + r;
    char* Qp = smem + 43008 + r * 272;
    __syncthreads();
    for (int mt2 = 0; mt2 < 2; ++mt2) {
      if (kbase + mt2 * 128 >= TS) break;
      const u16* arow = ck + (size_t)(kbase + mt2 * 128) * 256;
      f32x16 acc[2][2];
      gemm_main_t<2>(arow, 256, wk, 256, 256, smem, acc);
      {
        const float* Cs = (const float*)smem;
        for (int it = 0; it < 16; ++it) {
          const int idx = tid + 256 * it, row = idx >> 5, c4 = (idx & 31) * 4;
          const float4 v = *(const float4*)&Cs[row * 132 + c4];
          float ss = v.x * v.x + v.y * v.y + v.z * v.z + v.w * v.w;
          for (int mm = 1; mm < 32; mm <<= 1) ss += __shfl_xor(ss, mm);
          const float rs = rsqrtf(ss * (1.0f / 128.0f) + EPS);
          u32x2 ov; ov[0] = pack2(v.x * rs, v.y * rs); ov[1] = pack2(v.z * rs, v.w * rs);
          *(u32x2*)(sK + (size_t)(mt2 * 128 + row) * 128 + c4) = ov;
        }
      }
      __syncthreads();
      gemm_main_t<2>(wv, 256, arow, 256, 256, smem, acc);
      {
        const float* Cs = (const float*)smem;
        for (int it = 0; it < 16; ++it) {
          const int idx = tid + 256 * it, row = idx >> 5, c4 = (idx & 31) * 4;
          const float4 v = *(const float4*)&Cs[row * 132 + c4];
          u32x2 ov; ov[0] = pack2(v.x, v.y); ov[1] = pack2(v.z, v.w);
          *(u32x2*)(sV + (size_t)row * 256 + mt2 * 128 + c4) = ov;
        }
      }
      __syncthreads();
    }
    asm volatile("s_waitcnt vmcnt(0)" ::: "memory");
    __syncthreads();
    __builtin_amdgcn_fence(__ATOMIC_ACQUIRE, "agent");
    bf16x8 qf[4];
#pragma unroll
    for (int s = 0; s < 4; ++s) qf[s] = *(const bf16x8*)(p.Qb + (size_t)grow * 1536 + h * 192 + s * 16 + hh * 8);
    if (w == 0) {
#pragma unroll
      for (int s = 0; s < 8; ++s) *(bf16x8*)(Qp + (s * 16 + hh * 8) * 2) = *(const bf16x8*)(p.Qb + (size_t)grow * 1536 + h * 192 + 64 + s * 16 + hh * 8);
    }
    {
      const int ntl = (TS - kbase) >= 256 ? 4 : ((TS - kbase) + 63) / 64;
      u32x4 pk[4], pp[2], pv[4];
      auto tload = [&](int t4) {
        const int key0 = kbase + t4 * 64;
#pragma unroll
        for (int i = 0; i < 4; ++i) { const int cc = tid + 256 * i; pk[i] = *(const u32x4*)(sK + (size_t)(t4 * 64 + (cc >> 4)) * 128 + (cc & 15) * 8); }
#pragma unroll
        for (int i = 0; i < 2; ++i) {
          const int cc = tid + 256 * i, row = cc >> 3;
          u32x4 v; v[0] = 0; v[1] = 0; v[2] = 0; v[3] = 0;
          if (key0 + row < TS) v = *(const u32x4*)(kpe + (size_t)(key0 + row) * 64 + (cc & 7) * 8);
          pp[i] = v;
        }
#pragma unroll
        for (int i = 0; i < 4; ++i) { const int cc = tid + 256 * i; pv[i] = *(const u32x4*)(sV + (size_t)(cc >> 3) * 256 + t4 * 64 + (cc & 7) * 8); }
      };
      tload(0);
      for (int t4 = 0; t4 < ntl; ++t4) {
        const int key0 = kbase + t4 * 64;
        const int nvalid = (TS - key0) < 64 ? (TS - key0) : 64;
#pragma unroll
        for (int i = 0; i < 4; ++i) { const int cc = tid + 256 * i; *(u32x4*)(Ks + (cc >> 4) * 400 + (cc & 15) * 16) = pk[i]; }
#pragma unroll
        for (int i = 0; i < 2; ++i) { const int cc = tid + 256 * i; *(u32x4*)(Ks + (cc >> 3) * 400 + 256 + (cc & 7) * 16) = pp[i]; }
#pragma unroll
        for (int i = 0; i < 4; ++i) {
          const int cc = tid + 256 * i; char* d = Vts + (cc >> 3) * 136 + (cc & 7) * 16;
          u32x2 a, bq; a[0] = pv[i][0]; a[1] = pv[i][1]; bq[0] = pv[i][2]; bq[1] = pv[i][3];
          *(u32x2*)d = a; *(u32x2*)(d + 8) = bq;
        }
        __syncthreads();
        if (t4 + 1 < ntl) tload(t4 + 1);
        if ((w & 1) == 0 || nvalid == 64) attn_step_part(Ks, Vts, Qp, qf, o, m, l, r, hh, w & 1, w >> 1);
        __syncthreads();
      }
    }
  }
  {
    int t2 = threadIdx.x; asm volatile("" : "+v"(t2));
    const int w2 = t2 >> 6, ln2 = t2 & 63, r2 = ln2 & 31, h2 = (ln2 >> 5) & 1;
    const float lt = l + __shfl_xor(l, 32);
    float* cb = (float*)smem;
    __syncthreads();
    if (w2 & 1) {
      float* d = cb + (w2 >> 1) * 34 * 64 + ln2;
      d[0] = m; d[64] = lt;
#pragma unroll
      for (int d2 = 0; d2 < 2; ++d2)
#pragma unroll
        for (int i = 0; i < 16; ++i) d[(2 + d2 * 16 + i) * 64] = o[d2][i];
    }
    __syncthreads();
    if (!(w2 & 1)) {
      const float* d = cb + (w2 >> 1) * 34 * 64 + ln2;
      const float mB = d[0], lB = d[64];
      const float M = fmaxf(m, mB);
      const float fa = __builtin_amdgcn_exp2f(m - M), fb = __builtin_amdgcn_exp2f(mB - M);
      const float inv = 1.0f / (lt * fa + lB * fb);
      const int grow2 = RP + sb * 32 + r2;
#pragma unroll
      for (int d2 = 0; d2 < 2; ++d2)
#pragma unroll
        for (int gq = 0; gq < 4; ++gq) {
          float v[4];
#pragma unroll
          for (int e = 0; e < 4; ++e) v[e] = (o[d2][4 * gq + e] * fa + d[(2 + d2 * 16 + 4 * gq + e) * 64] * fb) * inv;
          u32x2 ov; ov[0] = pack2(v[0], v[1]); ov[1] = pack2(v[2], v[3]);
          *(u32x2*)(p.ao + (size_t)grow2 * 1024 + h * 128 + ((w2 >> 1) * 2 + d2) * 32 + 8 * gq + 4 * h2) = ov;
        }
    }
    __syncthreads();
  }
}

DI void phase_attn(const Params& p, char* smem, unsigned xcc) {
  int* sh = (int*)(smem + 76 * 1024 - 16);
  const int q0 = (int)(xcc & 7u);
  for (;;) {
    __syncthreads();
    if (threadIdx.x == 0) {
      int q = q0, li = 1 << 30;
      for (int d = 0; d < 8; ++d) {
        q = (q0 + d) & 7;
        li = atomicAdd(p.counter + q * 16, 1);
        if (li < 144) break;
      }
      sh[0] = li < 144 ? q * 256 + li : -1;
    }
    __syncthreads();
    const int code = sh[0];
    if (code < 0) break;
    const int q = code >> 8, li = code & 255;
    if (li < 16) { const int sb = 2 * q + (li >> 3), h = li & 7; attn_sample_item(p, smem, sb * 8 + h, sb, h); }
    else { const int desc = li >= 80 ? 1 : 0; const int bh = 2 * q + desc; attn_prompt_item(p, smem, bh >> 3, bh & 7, 63 - (li - 16 - 64 * desc), desc); }
  }
}

#define XB_TMO      128
#define XB_XCNT(j)  (256  + 64 * (j))
#define XB_XSUB(j)  (1280 + 64 * (j))
#define XB_XGEN(j)  (2304 + 64 * (j))
#define XB_TOP      3328
#define XB_TOPGEN   3392
#define XCD_BAR_WORDS 3456
#define XB_SPIN_CAP (1u << 20)
#define LAS __attribute__((address_space(3)))
DI unsigned xb_ld(unsigned* p)              { return __hip_atomic_load(p, __ATOMIC_RELAXED, __HIP_MEMORY_SCOPE_AGENT); }
DI unsigned xb_add(unsigned* p, unsigned v) { return __hip_atomic_fetch_add(p, v, __ATOMIC_RELAXED, __HIP_MEMORY_SCOPE_AGENT); }
DI unsigned xb_xcc_id() { return (unsigned)__builtin_amdgcn_s_getreg((3 << 11) | 20) & 0xFu; }
#define XB_SPIN(cond, bar) do { unsigned _sp = 0; while (cond) { __builtin_amdgcn_s_sleep(1); \
    if ((++_sp & 255u) == 0u) { if (xb_ld(&(bar)[XB_TMO])) break; if (_sp > XB_SPIN_CAP) { atomicAdd(&(bar)[XB_TMO], 1u); break; } } } } while (0)
struct XcdBarrier { unsigned* bar; unsigned x; volatile LAS unsigned* st; };
DI XcdBarrier xcd_barrier_post(unsigned* bar, volatile LAS unsigned* st) {
  XcdBarrier b; b.bar = bar; b.x = xb_xcc_id(); b.st = st;
  if (threadIdx.x == 0) (void)xb_add(&bar[XB_XCNT(b.x)], 1u);
  return b;
}
DI void xcd_barrier_complete(unsigned* bar, unsigned x, unsigned& nloc, unsigned& nx) {
  const unsigned G = gridDim.x * gridDim.y * gridDim.z;
  unsigned sum, cnt, mine, sp = 0u;
  for (;;) {
    sum = 0u; cnt = 0u; mine = 0u;
#pragma unroll
    for (unsigned j = 0; j < 16; ++j) { const unsigned c = xb_ld(&bar[XB_XCNT(j)]); sum += c; cnt += (c > 0u) ? 1u : 0u; mine = (j == x) ? c : mine; }
    if (sum == G) break;
    __builtin_amdgcn_s_sleep(1);
    if ((++sp & 255u) == 0u) { if (xb_ld(&bar[XB_TMO])) break; if (sp > XB_SPIN_CAP) { atomicAdd(&bar[XB_TMO], 1u); break; } }
  }
  nloc = mine > 0u ? mine : 1u; nx = cnt > 0u ? cnt : 1u;
}
DI void xcd_barrier(const XcdBarrier& b) {
  asm volatile("s_waitcnt vmcnt(0)" ::: "memory");
  __syncthreads();
  if (threadIdx.x == 0) {
    unsigned* bar = b.bar;
    __builtin_amdgcn_s_waitcnt(0);
    unsigned nloc = b.st[0], nx = b.st[1];
    if (nloc == 0u) { xcd_barrier_complete(bar, b.x, nloc, nx); b.st[0] = nloc; b.st[1] = nx; }
    const unsigned old = xb_add(&bar[XB_XSUB(b.x)], 1u);
    const unsigned gen = old / nloc;
    if (old + 1u == (gen + 1u) * nloc) {
      __builtin_amdgcn_fence(__ATOMIC_RELEASE, "agent");
      asm volatile("s_waitcnt vmcnt(0)" ::: "memory");
      const unsigned og = xb_add(&bar[XB_TOP], 1u);
      const unsigned tg = og / nx;
      if (og + 1u == (tg + 1u) * nx) xb_add(&bar[XB_TOPGEN], 1u);
      else XB_SPIN(xb_ld(&bar[XB_TOPGEN]) == tg, bar);
      __builtin_amdgcn_fence(__ATOMIC_ACQUIRE, "agent");
      xb_add(&bar[XB_XGEN(b.x)], 1u);
      asm volatile("s_waitcnt vmcnt(0)" ::: "memory");
    } else {
      XB_SPIN(xb_ld(&bar[XB_XGEN(b.x)]) == gen, bar);
      __builtin_amdgcn_fence(__ATOMIC_ACQUIRE, "agent");
      asm volatile("s_waitcnt vmcnt(0)" ::: "memory");
    }
  }
  __syncthreads();
}

__global__ void __launch_bounds__(256, 2) yoco_megakernel(const Params p, int ph0, int ph1) {
  extern __shared__ __attribute__((aligned(16))) char smem[];
  const int bid = blockIdx.x, G = gridDim.x;
  __shared__ uint4 xb_words;
  if (threadIdx.x == 0) xb_words = make_uint4(0u, 0u, 0u, 0u);
  __syncthreads();
  (void)xcd_barrier_post(p.bar, (volatile LAS unsigned*)&xb_words);
#define XBH (XcdBarrier{p.bar, xb_xcc_id(), (volatile LAS unsigned*)&xb_words})
  if (ph0 == 12345) cg::this_grid().sync();
#define PH_BEGIN(n) if (EN(n) && ph0 <= (n) && (n) < ph1) {
#define PH_END(n) } if (ph0 <= (n) && (n) + 1 < ph1) { const XcdBarrier xbb = XBH; xcd_barrier(xbb); }
  PH_BEGIN(0) phase_prep(p, smem); PH_END(0)
  PH_BEGIN(1) { GemmDesc g{p.xb, DM, p.Wgla_in, DM, DM, 132, 25, EPI_GLA_IN, 0, nullptr, nullptr, nullptr, 0, 1, 1}; gemm_phase(p, g, smem, 0, xb_xcc_id()); } PH_END(1)
  PH_BEGIN(2) phase_gla_a(p, smem); PH_END(2)
  PH_BEGIN(3) phase_gla_scan(p); PH_END(3)
  PH_BEGIN(4) phase_gla_c(p, smem); PH_END(4)
  PH_BEGIN(5) { GemmDesc g{p.Rg, DM, p.Wgla_out, DM, DM, 132, 8, EPI_RESID, 0, p.in[0], p.in[1], p.out + O_Y, 1, 0, 1}; gemm_phase(p, g, smem, 1, xb_xcc_id()); } PH_END(5)
  PH_BEGIN(6) { GemmDesc g{p.xb, DM, p.Wffn_in[0], DM, DM, 132, 44, EPI_FFN_IN, 0, nullptr, nullptr, nullptr, 0, 8, 12}; gemm_phase(p, g, smem, 2, xb_xcc_id()); } PH_END(6)
  PH_BEGIN(7) { GemmDesc g{p.act, DFF, p.Wffn_out[0], DFF, DFF, 132, 8, EPI_RESID, 0, p.out + O_Y, p.out + O_Y + (size_t)RP * DM, p.out + O_Y, 1, 0, 1}; gemm_phase(p, g, smem, 3, xb_xcc_id()); } PH_END(7)
  PH_BEGIN(8) { GemmDesc g{p.xb, DM, p.Wdkvq, DM, DM, 132, 7, EPI_DKVQ, 0, nullptr, nullptr, nullptr, 0, 8, 1}; gemm_phase(p, g, smem, 4, xb_xcc_id()); } PH_END(8)
  PH_BEGIN(9) phase_e2(p); PH_END(9)
  PH_BEGIN(10) {
    { GemmDesc g{p.ACKVp, 256, p.Wukv, 256, 256, 128, 16, EPI_UKV, 0, nullptr, nullptr, nullptr, 0, 0, 1}; gemm_phase(p, g, smem, 5, xb_xcc_id()); }
    const int n1 = 128 * 16;
    { GemmDesc g{p.CQN, 512, p.Wuq, 512, 512, 132, 12, EPI_UQ, 0, nullptr, nullptr, nullptr, 0, 0, 1}; gemm_phase(p, g, smem, 6, xb_xcc_id()); }
  } PH_END(10)
  PH_BEGIN(11) phase_attn(p, smem, xb_xcc_id()); PH_END(11)
  PH_BEGIN(12) { GemmDesc g{p.ao, DM, p.Wmla_out, DM, DM, 132, 8, EPI_RESID, 0, p.out + O_Y, p.out + O_Y + (size_t)RP * DM, p.out + O_Y, 1, 0, 1}; gemm_phase(p, g, smem, 7, xb_xcc_id()); } PH_END(12)
  PH_BEGIN(13) { GemmDesc g{p.xb, DM, p.Wffn_in[1], DM, DM, 132, 44, EPI_FFN_IN, 1, nullptr, nullptr, nullptr, 0, 8, 12}; gemm_phase(p, g, smem, 8, xb_xcc_id()); } PH_END(13)
  PH_BEGIN(14) { GemmDesc g{p.act, DFF, p.Wffn_out[1], DFF, DFF, 132, 8, EPI_RESID, 1, p.out + O_Y, p.out + O_Y + (size_t)RP * DM, p.out + O_Y, 0, 0, 1}; gemm_phase(p, g, smem, 9, xb_xcc_id()); }
  }
}

static inline size_t al(size_t x) { return (x + 255) & ~(size_t)255; }

extern "C" void kernel_launch(void* const* d_in, const int* in_sizes, int n_in, void* d_out, int out_size, void* d_ws, size_t ws_size, hipStream_t stream) {
  Params p;
  memset(&p, 0, sizeof(p));
  for (int i = 0; i < 30; ++i) p.in[i] = (const float*)d_in[i];
  p.out = (float*)d_out;
  char* ws = (char*)d_ws; size_t off = 0;
  auto take = [&](size_t bytes) { char* q = ws + off; off = al(off + bytes); return q; };
  p.Wgla_in = (u16*)take((size_t)3200 * 1024 * 2);
  p.Wgla_out = (u16*)take((size_t)1024 * 1024 * 2);
  for (int l = 0; l < 2; ++l) p.Wffn_in[l] = (u16*)take((size_t)5632 * 1024 * 2);
  for (int l = 0; l < 2; ++l) p.Wffn_out[l] = (u16*)take((size_t)1024 * 2816 * 2);
  p.Wdkvq = (u16*)take((size_t)896 * 1024 * 2);
  p.Wukv = (u16*)take((size_t)2048 * 256 * 2);
  p.Wuq = (u16*)take((size_t)1536 * 512 * 2);
  p.Wmla_out = (u16*)take((size_t)1024 * 1024 * 2);
  p.rsp = (float*)take((size_t)8 * R * 4);
  p.counter = (int*)take(8192);
  p.bar = (unsigned*)take(XCD_BAR_WORDS * 4);
  p.xb = (u16*)take((size_t)R * 1024 * 2 + 65536);
  p.ACKVs = p.xb;
  const size_t regionA = off;
  p.Rg = (u16*)take((size_t)R * 1024 * 2);
  p.Vt = (u16*)take((size_t)1024 * R * 2 + 4096);
  p.US = (u16*)take((size_t)NSLOT * 32768 * 2);
  p.dec = (float*)take((size_t)NSLOT * 128 * 4);
  size_t maxoff = off;
  p.Qg = (u16*)d_out;
  p.Kg = p.Qg + (size_t)R * 512;
  p.GA = (float*)(p.Kg + (size_t)R * 512);
  off = regionA;
  p.act = (u16*)take((size_t)R * DFF * 2);
  if (off > maxoff) maxoff = off;
  off = regionA;
  p.CQN = (u16*)take((size_t)R * 512 * 2);
  p.ACKVp = (u16*)take((size_t)RP * 256 * 2);
  p.AKPEp = p.Wffn_in[0];
  p.AKPEs = p.Wffn_in[0] + (size_t)RP * 64 + 128;
  p.Knp = (u16*)take((size_t)16 * 8192 * 128 * 2);
  p.Vtp = (u16*)take((size_t)16 * 128 * 8192 * 2);
  p.Qb = (u16*)take((size_t)R * 1536 * 2);
  p.ao = (u16*)take((size_t)R * 1024 * 2);
  p.RAW = (float*)p.Knp;
  if (off > maxoff) maxoff = off;
  if (maxoff > ws_size) { fprintf(stderr, "workspace too small: need %zu have %zu\n", maxoff, ws_size); return; }

  int t0 = 0, nj = 0;
  auto addj = [&](const float* src, const float* gain, u16* dst, int ld, int K, int nblk, int kind, int ncols) {
    WJob& j = p.wj[nj++]; j.src = src; j.gain = gain; j.dst = dst; j.ld = ld; j.K = K; j.nblk = nblk; j.kind = kind; j.ncols = ncols; j.tile0 = t0; t0 += nblk * (K / 64);
  };
  const float* nm = p.in[6]; const float* nf = p.in[7];
  addj(p.in[12], nm, p.Wgla_in, 3072, 1024, 48, 0, 64);
  addj(p.in[13], nm, p.Wgla_in + (size_t)3072 * 1024, 16, 1024, 1, 1, 16);
  addj(p.in[13], nm, p.Wgla_in + (size_t)3136 * 1024, 16, 1024, 1, 1, 0);
  addj(p.in[17], nullptr, p.Wgla_out, 1024, 1024, 16, 0, 64);
  addj(p.in[8], nf, p.Wffn_in[0], 5632, 1024, 88, 2, 64);
  addj(p.in[8] + (size_t)1024 * 5632, nf + 1024, p.Wffn_in[1], 5632, 1024, 88, 2, 64);
  addj(p.in[11], nullptr, p.Wffn_out[0], 1024, 2816, 16, 0, 64);
  addj(p.in[11] + (size_t)2816 * 1024, nullptr, p.Wffn_out[1], 1024, 2816, 16, 0, 64);
  addj(p.in[25], p.in[24], p.Wdkvq, 320, 1024, 5, 0, 64);
  addj(p.in[25], p.in[24], p.Wdkvq + (size_t)320 * 1024, 320, 1024, 1, 1, 0);
  addj(p.in[18], nm + 1024, p.Wdkvq + (size_t)384 * 1024, 512, 1024, 8, 0, 64);
  addj(p.in[27], nullptr, p.Wukv, 2048, 256, 32, 0, 64);
  addj(p.in[20], nullptr, p.Wuq, 1536, 512, 24, 4, 64);
  addj(p.in[23], nullptr, p.Wmla_out, 1024, 1024, 16, 0, 64);
  p.n_wtiles = t0;

  (void)hipFuncSetAttribute((const void*)yoco_megakernel, hipFuncAttributeMaxDynamicSharedMemorySize, LDS_BYTES);
  int dev = 0, cus = 0, per_cu = 0;
  (void)hipGetDevice(&dev);
  (void)hipDeviceGetAttribute(&cus, hipDeviceAttributeMultiprocessorCount, dev);
  (void)hipOccupancyMaxActiveBlocksPerMultiprocessor(&per_cu, yoco_megakernel, 256, LDS_BYTES);
  if (per_cu < 1) per_cu = 1;
  if (per_cu > 2) per_cu = 2;
  const int grid = cus * per_cu;
#if MULTI_LAUNCH
  for (int ph = 0; ph < NPH; ++ph) hipLaunchKernelGGL(yoco_megakernel, dim3(grid), dim3(256), LDS_BYTES, stream, p, ph, ph + 1);
#else
  (void)hipMemsetAsync(p.bar, 0, XCD_BAR_WORDS * 4, stream);
  int ph0 = 0, ph1 = NPH;
  void* args[] = {(void*)&p, (void*)&ph0, (void*)&ph1};
  hipError_t e = hipLaunchCooperativeKernel((const void*)yoco_megakernel, dim3(grid), dim3(256), args, LDS_BYTES, stream);
  if (e != hipSuccess) fprintf(stderr, "cooperative launch failed: %s (grid %d)\n", hipGetErrorString(e), grid);
#endif
}
```
